# Optimizing an MI355X kernel written in HIP

```python
import math
import jax, jax.numpy as jnp
from jax import lax
import numpy as np


D_MODEL = 1024
BATCH = 8
SEQ = 2048
DEPTH = 4

N_A_LAYERS = DEPTH // 2
N_B_LAYERS = DEPTH - N_A_LAYERS
POOL_WINDOWS = (2, 4, 8, 16)
N_POOL_GROUPS = len(POOL_WINDOWS)
POOL_GROUP = D_MODEL // N_POOL_GROUPS
HEAD_DIM = 64
N_HEADS = D_MODEL // HEAD_DIM
MOBA_BLOCK = 256
MOBA_TOPK = 3
Q_BLOCK = 128
NUM_BUCKETS = 32
MAX_DISTANCE = 128
D_FF = -(-8 * D_MODEL // (3 * 256)) * 256
EPS = 1e-6

kernel_name = 'yoco_pool_moba_hybrid'


def rmsnorm(x, g):
    xf = x.astype(jnp.float32)
    y = xf * lax.rsqrt(jnp.mean(xf * xf, axis=-1, keepdims=True) + EPS)
    return (y * g.astype(jnp.float32)).astype(x.dtype)


def pool_mixer(h, w, scale):
    B, T, D = h.shape
    hf = h.astype(jnp.float32)
    csum = jnp.concatenate([jnp.zeros((B, 1, D), jnp.float32), jnp.cumsum(hf, axis=1)], axis=1)
    t = jnp.arange(T)
    outs = []
    for g, win in enumerate(POOL_WINDOWS):
        sl = slice(g * POOL_GROUP, (g + 1) * POOL_GROUP)
        start = jnp.maximum(t + 1 - win, 0)
        cnt = (t + 1 - start).astype(jnp.float32)
        window_sum = csum[:, 1:, sl] - jnp.take(csum[:, :, sl], start, axis=1)
        outs.append(window_sum / cnt[None, :, None] - hf[:, :, sl])
    d = jnp.stack(outs, axis=2).astype(h.dtype)
    y = jnp.einsum('btgc,gce->btge', d, w).reshape(B, T, D)
    return y * scale


def swiglu(h, w_gate_up, w_down):
    gu = h @ w_gate_up
    gate, up = jnp.split(gu, 2, axis=-1)
    return (jax.nn.silu(gate) * up) @ w_down


def rel_bucket(n):
    max_exact = NUM_BUCKETS // 2
    nf = jnp.maximum(n, max_exact).astype(jnp.float32)
    large = max_exact + (jnp.log(nf / max_exact) / math.log(MAX_DISTANCE / max_exact)
                         * (NUM_BUCKETS - max_exact)).astype(jnp.int32)
    large = jnp.minimum(large, NUM_BUCKETS - 1)
    return jnp.where(n < max_exact, n, large)


def shared_kv(x, g, w_kv):
    B, T, D = x.shape
    h = rmsnorm(x, g)
    kv = h @ w_kv
    k, v = jnp.split(kv, 2, axis=-1)
    n_blocks = -(-T // MOBA_BLOCK)
    pad = n_blocks * MOBA_BLOCK - T

    def to_blocks(a):
        a = a.reshape(B, T, N_HEADS, HEAD_DIM).transpose(0, 2, 1, 3)
        a = jnp.pad(a, ((0, 0), (0, 0), (0, pad), (0, 0)))
        return a.reshape(B, N_HEADS, n_blocks, MOBA_BLOCK, HEAD_DIM)

    k_blocks = to_blocks(k)
    v_blocks = to_blocks(v)
    k_mean = jnp.mean(k_blocks.astype(jnp.float32), axis=3).astype(k_blocks.dtype)
    return k_blocks, v_blocks, k_mean


def moba_attention(q, k_blocks, v_blocks, k_mean, rel_bias):
    B, T = q.shape[0], q.shape[1]
    n_q = T // Q_BLOCK
    n_blocks = k_blocks.shape[2]
    topk = min(MOBA_TOPK, n_blocks)
    scale = HEAD_DIM ** -0.5
    h_idx = jnp.arange(N_HEADS)[:, None, None]
    bias_t = rel_bias.T.astype(jnp.float32)
    q_blocks = q.transpose(0, 2, 1, 3).reshape(B, N_HEADS, n_q, Q_BLOCK, HEAD_DIM)
    q_blocks = q_blocks.transpose(0, 2, 1, 3, 4).reshape(B * n_q, N_HEADS, Q_BLOCK, HEAD_DIM)
    b_idx = jnp.repeat(jnp.arange(B), n_q)
    qb_idx = jnp.tile(jnp.arange(n_q), B)
    j_blk = jnp.arange(MOBA_BLOCK)

    def step(args):
        qblk, b, qb = args
        kb = k_blocks[b]
        vb = v_blocks[b]
        km = k_mean[b]
        qs = qb * Q_BLOCK
        own = qs // MOBA_BLOCK
        qpos = qs + jnp.arange(Q_BLOCK)
        gate = jnp.einsum('hqd,hnd->hqn', qblk, km).astype(jnp.float32)
        gate = jnp.where(jnp.arange(n_blocks)[None, None, :] < own, gate, -jnp.inf)
        _, sel = lax.top_k(gate, topk)
        sel_valid = jnp.arange(topk) < jnp.minimum(own, topk)
        k_sel = kb[h_idx, sel]
        v_sel = vb[h_idx, sel]
        s_sel = jnp.einsum('hqd,hqkjd->hqkj', qblk, k_sel).astype(jnp.float32) * scale
        kpos_sel = sel[..., None] * MOBA_BLOCK + j_blk
        k_own = lax.dynamic_index_in_dim(kb, own, axis=1, keepdims=False)
        v_own = lax.dynamic_index_in_dim(vb, own, axis=1, keepdims=False)
        s_own = jnp.einsum('hqd,hjd->hqj', qblk, k_own).astype(jnp.float32) * scale
        kpos_own = own * MOBA_BLOCK + j_blk
        L_sel = topk * MOBA_BLOCK
        s = jnp.concatenate([s_sel.reshape(N_HEADS, Q_BLOCK, L_sel), s_own], axis=-1)
        kpos = jnp.concatenate([kpos_sel.reshape(N_HEADS, Q_BLOCK, L_sel),
                                jnp.broadcast_to(kpos_own[None, None, :], (N_HEADS, Q_BLOCK, MOBA_BLOCK))], axis=-1)
        valid_sel = jnp.broadcast_to(sel_valid[None, None, :, None], (N_HEADS, Q_BLOCK, topk, MOBA_BLOCK)).reshape(N_HEADS, Q_BLOCK, L_sel)
        valid_own = jnp.broadcast_to(kpos_own[None, None, :] <= qpos[None, :, None], (N_HEADS, Q_BLOCK, MOBA_BLOCK))
        valid = jnp.concatenate([valid_sel, valid_own], axis=-1)
        bucket = rel_bucket(jnp.maximum(qpos[None, :, None] - kpos, 0))
        bias = bias_t[h_idx, bucket]
        s = jnp.where(valid, s + bias, -jnp.inf)
        p = jax.nn.softmax(s, axis=-1).astype(vb.dtype)
        p_sel = p[..., :L_sel].reshape(N_HEADS, Q_BLOCK, topk, MOBA_BLOCK)
        p_own = p[..., L_sel:]
        return (jnp.einsum('hqkj,hqkjd->hqd', p_sel, v_sel)
                + jnp.einsum('hqj,hjd->hqd', p_own, v_own))

    o = lax.map(step, (q_blocks, b_idx, qb_idx))
    o = o.reshape(B, n_q, N_HEADS, Q_BLOCK, HEAD_DIM).transpose(0, 1, 3, 2, 4)
    return o.reshape(B, T, D_MODEL)


def setup_inputs(seed: int = 0) -> dict:
    key = jax.random.key(seed)
    ks = jax.random.split(key, 14)
    f32 = jnp.float32
    nrm = lambda k, shape: jax.random.normal(k, shape, f32)
    x = nrm(ks[0], (BATCH, SEQ, D_MODEL))
    norm_mixer = 1.0 + 0.05 * nrm(ks[1], (DEPTH, D_MODEL))
    norm_ffn = 1.0 + 0.05 * nrm(ks[2], (DEPTH, D_MODEL))
    pool_w = nrm(ks[3], (N_A_LAYERS, N_POOL_GROUPS, POOL_GROUP, POOL_GROUP)) * POOL_GROUP ** -0.5
    pool_scale = 1.0 + 0.05 * nrm(ks[4], (N_A_LAYERS, D_MODEL))
    kv_norm = 1.0 + 0.05 * nrm(ks[5], (D_MODEL,))
    w_kv = nrm(ks[6], (D_MODEL, 2 * D_MODEL)) * D_MODEL ** -0.5
    w_q = nrm(ks[7], (N_B_LAYERS, D_MODEL, D_MODEL)) * D_MODEL ** -0.5
    w_o = nrm(ks[8], (N_B_LAYERS, D_MODEL, D_MODEL)) * D_MODEL ** -0.5
    rel_bias = 0.5 * nrm(ks[9], (NUM_BUCKETS, N_HEADS))
    w_gate_up = nrm(ks[10], (DEPTH, D_MODEL, 2 * D_FF)) * D_MODEL ** -0.5
    w_down = nrm(ks[11], (DEPTH, D_FF, D_MODEL)) * D_FF ** -0.5
    final_norm = 1.0 + 0.05 * nrm(ks[12], (D_MODEL,))
    return {'x': x, 'norm_mixer': norm_mixer, 'norm_ffn': norm_ffn, 'pool_w': pool_w,
            'pool_scale': pool_scale, 'kv_norm': kv_norm, 'w_kv': w_kv, 'w_q': w_q, 'w_o': w_o,
            'rel_bias': rel_bias, 'w_gate_up': w_gate_up, 'w_down': w_down, 'final_norm': final_norm}


def reference(x, norm_mixer, norm_ffn, pool_w, pool_scale, kv_norm, w_kv, w_q, w_o,
              rel_bias, w_gate_up, w_down, final_norm):
    B, T, D = x.shape
    k_blocks = v_blocks = k_mean = None
    for layer in range(DEPTH):
        if layer < N_A_LAYERS:
            x = x + pool_mixer(rmsnorm(x, norm_mixer[layer]), pool_w[layer], pool_scale[layer])
        else:
            j = layer - N_A_LAYERS
            if j == 0:
                k_blocks, v_blocks, k_mean = shared_kv(x, kv_norm, w_kv)
            h = rmsnorm(x, norm_mixer[layer])
            q = (h @ w_q[j]).reshape(B, T, N_HEADS, HEAD_DIM)
            o = moba_attention(q, k_blocks, v_blocks, k_mean, rel_bias)
            x = x + o @ w_o[j]
        x = x + swiglu(rmsnorm(x, norm_ffn[layer]), w_gate_up[layer], w_down[layer])
    return rmsnorm(x, final_norm)
```

```cpp
#include <hip/hip_runtime.h>
#include <cstdio>
#include <cstdint>

#define LAS __attribute__((address_space(3)))
typedef unsigned short bf16_t;
typedef short bf16x8 __attribute__((ext_vector_type(8)));
typedef float f32x4 __attribute__((ext_vector_type(4)));
typedef unsigned u32x4 __attribute__((ext_vector_type(4)));
typedef unsigned u32x2 __attribute__((ext_vector_type(2)));
typedef float f32x2_t __attribute__((ext_vector_type(2)));
typedef __bf16 bf16x2_t __attribute__((ext_vector_type(2)));

constexpr int BATCH = 8, SEQ = 2048, D = 1024, M = BATCH * SEQ, DFF = 2816, NGU = 2 * DFF, NH = 16, HD = 64, NBLK = SEQ / 256;
constexpr float EPS = 1e-6f;
constexpr float QSCALE = 0.125f * 1.4426950408889634f;
constexpr float LOG2E = 1.4426950408889634f;

constexpr size_t MiB = 1u << 20;
constexpr size_t WS_CTL = 0;
constexpr size_t WS_KMP = 1 * MiB;
constexpr size_t WS_SS = 2 * MiB;
constexpr size_t WS_BIAS = 3 * MiB;
constexpr size_t WS_WPOOL = 4 * MiB;
constexpr size_t WS_WKVQ = 5 * MiB;
constexpr size_t WS_WQ1 = 11 * MiB;
constexpr size_t WS_WO = 13 * MiB;
constexpr size_t WS_WGU = 17 * MiB;
constexpr size_t WS_WDN = 61 * MiB;
constexpr size_t WS_SS2 = 83 * MiB;
constexpr size_t WS_XB = 84 * MiB;
constexpr size_t WS_K = 116 * MiB;
constexpr size_t WS_V = 148 * MiB;
constexpr size_t WS_ACT = 180 * MiB;
constexpr size_t WS_Q = WS_ACT, WS_O = WS_ACT + 32 * MiB, WS_DP = WS_ACT;
constexpr size_t WS_END = 268 * MiB;
constexpr size_t WGU_STRIDE = (size_t)NGU * D, WDN_STRIDE = (size_t)D * DFF;

__device__ __forceinline__ unsigned cvtpk(float lo, float hi) { f32x2_t v = {lo, hi}; bf16x2_t b = __builtin_convertvector(v, bf16x2_t); return __builtin_bit_cast(unsigned, b); }
__device__ __forceinline__ void st16_wt(void* p, u32x4 v) { asm volatile("global_store_dwordx4 %0, %1, off sc1\n\ts_nop 1" :: "v"(p), "v"(v) : "memory"); }
__device__ __forceinline__ float bf_lo(unsigned w) { return __uint_as_float(w << 16); }
__device__ __forceinline__ float bf_hi(unsigned w) { return __uint_as_float(w & 0xffff0000u); }
template <int CTRL> __device__ __forceinline__ float dpp_f(float v) { return __uint_as_float((unsigned)__builtin_amdgcn_update_dpp(0, (int)__float_as_uint(v), CTRL, 0xf, 0xf, false)); }
__device__ __forceinline__ float row16_sum(float v) { v += dpp_f<0x128>(v); v += dpp_f<0x124>(v); v += dpp_f<0x122>(v); v += dpp_f<0x121>(v); return v; }
__device__ __forceinline__ float xor16_sum(float v) { auto r = __builtin_amdgcn_permlane16_swap(__float_as_uint(v), __float_as_uint(v), false, false); return __uint_as_float(r[0]) + __uint_as_float(r[1]); }
__device__ __forceinline__ float xor32_sum(float v) { auto r = __builtin_amdgcn_permlane32_swap(__float_as_uint(v), __float_as_uint(v), false, false); return __uint_as_float(r[0]) + __uint_as_float(r[1]); }
__device__ __forceinline__ float wave_sum(float v) { return xor32_sum(xor16_sum(row16_sum(v))); }
__device__ __forceinline__ float lane_bcast(float v, int l) { return __uint_as_float((unsigned)__builtin_amdgcn_readlane((int)__float_as_uint(v), l)); }
__device__ __forceinline__ float row_rstd(const float* SS, int row) {
    const f32x4* p = (const f32x4*)(SS + (size_t)row * 16);
    const f32x4 a = p[0], b = p[1], c = p[2], d = p[3];
    const float s = (((a.x + a.y) + (a.z + a.w)) + ((b.x + b.y) + (b.z + b.w))) + (((c.x + c.y) + (c.z + c.w)) + ((d.x + d.y) + (d.z + d.w)));
    return 1.0f / sqrtf(s * (1.0f / D) + EPS);
}
__device__ __forceinline__ int rel_bucket(int n) {
    if (n < 16) return n;
    int b = 16;
    b += (n >= 19); b += (n >= 21); b += (n >= 24); b += (n >= 27); b += (n >= 31); b += (n >= 35); b += (n >= 40); b += (n >= 46);
    b += (n >= 52); b += (n >= 59); b += (n >= 67); b += (n >= 77); b += (n >= 87); b += (n >= 99); b += (n >= 113);
    return b;
}

struct Params {
    const float* x; const float* norm_mixer; const float* norm_ffn; const float* pool_w; const float* pool_scale; const float* kv_norm;
    const float* w_kv; const float* w_q; const float* w_o; const float* rel_bias; const float* w_gate_up; const float* w_down; const float* final_norm;
    float* out; unsigned char* ws;
};

__device__ __forceinline__ void conv_item(const float* W, int ldw, int k0, int ns0, bf16_t* WT, int ldt, int nd0, const float* gk, const float* gn, float cs, LAS float* scr, int lane) {
    const int c4 = (lane & 7) * 4, kr = lane >> 3;
    f32x4 sn = (f32x4){cs, cs, cs, cs}; if (gn) sn = sn * *(const f32x4*)(gn + ns0 + c4);
    f32x4 w[8];
#pragma unroll
    for (int i = 0; i < 8; ++i) w[i] = __builtin_nontemporal_load((const f32x4*)(W + (size_t)(k0 + 8 * i + kr) * ldw + ns0 + c4));
#pragma unroll
    for (int i = 0; i < 8; ++i) { const int kk = 8 * i + kr; f32x4 v = w[i] * sn; if (gk) v = v * gk[k0 + kk];
        LAS float* d = scr + kk * 33 + c4; d[0] = v.x; d[1] = v.y; d[2] = v.z; d[3] = v.w; }
    asm volatile("s_waitcnt lgkmcnt(0)" ::: "memory");
    const int ch = lane & 7;
#pragma unroll
    for (int j = 0; j < 4; ++j) { const int n = (lane >> 3) + 8 * j; const LAS float* s = scr + (8 * ch) * 33 + n;
        u32x4 o; o.x = cvtpk(s[0 * 33], s[1 * 33]); o.y = cvtpk(s[2 * 33], s[3 * 33]); o.z = cvtpk(s[4 * 33], s[5 * 33]); o.w = cvtpk(s[6 * 33], s[7 * 33]);
        *(u32x4*)(WT + (size_t)(nd0 + n) * ldt + k0 + 8 * ch) = o; }
    asm volatile("s_waitcnt lgkmcnt(0)" ::: "memory");
}
constexpr int IT_POOL = 8 * 32, IT_KV = 16 * 64, IT_Q = 16 * 32, IT_O = 16 * 32, IT_GU = 16 * 176, IT_DN = 44 * 32;
constexpr int IT_TOTAL = IT_POOL + IT_KV + 2 * IT_Q + 2 * IT_O + 4 * IT_GU + 4 * IT_DN;
__device__ __forceinline__ void conv_dispatch(const Params& p, int it, LAS float* scr, int lane) {
    unsigned char* ws = p.ws;
    int r = it;
    if (r < IT_POOL) { const int lg = r >> 5, l = lg >> 2, g = lg & 3, q = r & 31, kb = q >> 3, nb = q & 7;
        conv_item(p.pool_w + (size_t)lg * 65536, 256, 64 * kb, 32 * nb, (bf16_t*)(ws + WS_WPOOL) + (size_t)l * 262144, 256, 256 * g + 32 * nb,
                  p.norm_mixer + l * D + 256 * g, p.pool_scale + l * D + 256 * g, 1.f, scr, lane); return; } r -= IT_POOL;
    if (r < IT_KV) { const int kb = r >> 6, nb = r & 63;
        conv_item(p.w_kv, 2048, 64 * kb, 32 * nb, (bf16_t*)(ws + WS_WKVQ), D, 32 * nb, p.kv_norm, nullptr, 1.f, scr, lane); return; } r -= IT_KV;
    if (r < 2 * IT_Q) { const int j = r / IT_Q, q = r % IT_Q, kb = q >> 5, nb = q & 31;
        bf16_t* dst = j == 0 ? (bf16_t*)(ws + WS_WKVQ) + (size_t)2048 * D : (bf16_t*)(ws + WS_WQ1);
        conv_item(p.w_q + (size_t)j * D * D, D, 64 * kb, 32 * nb, dst, D, 32 * nb, p.norm_mixer + (2 + j) * D, nullptr, QSCALE, scr, lane); return; } r -= 2 * IT_Q;
    if (r < 2 * IT_O) { const int j = r / IT_O, q = r % IT_O, kb = q >> 5, nb = q & 31;
        conv_item(p.w_o + (size_t)j * D * D, D, 64 * kb, 32 * nb, (bf16_t*)(ws + WS_WO) + (size_t)j * D * D, D, 32 * nb, nullptr, nullptr, 1.f, scr, lane); return; } r -= 2 * IT_O;
    if (r < 4 * IT_GU) { const int l = r / IT_GU, q = r % IT_GU, kb = q / 176, nb = q % 176;
        const int nd0 = 32 * nb, pn = nd0 >> 8, bj = (nd0 >> 7) & 1, i = nd0 & 127, ns0 = bj * DFF + 128 * pn + i;
        conv_item(p.w_gate_up + (size_t)l * D * NGU, NGU, 64 * kb, ns0, (bf16_t*)(ws + WS_WGU) + (size_t)l * WGU_STRIDE, D, nd0, p.norm_ffn + l * D, nullptr, 1.f, scr, lane); return; } r -= 4 * IT_GU;
    { const int l = r / IT_DN, q = r % IT_DN, kb = q >> 5, nb = q & 31;
        conv_item(p.w_down + (size_t)l * DFF * D, D, 64 * kb, 32 * nb, (bf16_t*)(ws + WS_WDN) + (size_t)l * WDN_STRIDE, DFF, 32 * nb, nullptr, nullptr, 1.f, scr, lane); }
}

__device__ __forceinline__ void rowprep(const float* x, bf16_t* XB, float* SS, int row, int lane) {
    const f32x4* xr = (const f32x4*)(x + (size_t)row * D) + lane;
    f32x4 v[4]; float s = 0.f; u32x2 w[4];
#pragma unroll
    for (int j = 0; j < 4; ++j) v[j] = __builtin_nontemporal_load(xr + 64 * j);
#pragma unroll
    for (int j = 0; j < 4; ++j) { w[j].x = cvtpk(v[j].x, v[j].y); w[j].y = cvtpk(v[j].z, v[j].w);
        const float a = bf_lo(w[j].x), b = bf_hi(w[j].x), c = bf_lo(w[j].y), d = bf_hi(w[j].y); s += (a * a + b * b) + (c * c + d * d); }
    s = wave_sum(s);
    u32x2* o = (u32x2*)(XB + (size_t)row * D) + lane;
#pragma unroll
    for (int j = 0; j < 4; ++j) o[64 * j] = w[j];
    if (lane < 16) SS[(size_t)row * 16 + lane] = lane == 0 ? s : 0.f;
}

__device__ __forceinline__ void final_row(const bf16_t* XB, float* out, const float* SS, const float* g, int row, int lane) {
    const float r = row_rstd(SS, row);
    const u32x2* xr = (const u32x2*)(XB + (size_t)row * D) + lane; f32x4* orow = (f32x4*)(out + (size_t)row * D) + lane; const f32x4* gr = (const f32x4*)g + lane;
#pragma unroll
    for (int j = 0; j < 4; ++j) { const u32x2 w = xr[64 * j]; const f32x4 gg = gr[64 * j]; const f32x4 v = (f32x4){bf_lo(w.x), bf_hi(w.x), bf_lo(w.y), bf_hi(w.y)}; orow[64 * j] = v * r * gg; }
}

struct Epi {
    const float* base; float* XF; bf16_t* XB; float* SS; bf16_t* ACT; bf16_t* Kb; bf16_t* Vb; bf16_t* Qb; float* KMP;
};
__device__ __forceinline__ float silu_mul(float g, float u) { return g * __builtin_amdgcn_rcpf(1.0f + __builtin_amdgcn_exp2f(g * -LOG2E)) * u; }

namespace pg8 {
#define PG8_LAS __attribute__((address_space(3)))
constexpr int BM = 256, BK = 64, HALF = 128, HTB = HALF * BK * 2  , STAGE_BYTES = 8 * HTB, NXCD = 8, WGM = 8;

#ifndef PG8_OLD_IMAGE
__host__ __device__ __forceinline__ int lds_byte(int r, int c) { return (r >> 3) * 1024 + (r & 7) * 128 + (((c >> 3) ^ ((r >> 1) & 7)) << 4) + (c & 7) * 2; }
__host__ __device__ __forceinline__ void stage_rc(int b, int& R, int& C) { const int st = b >> 10, sb = b & 1023, row = sb >> 7, chs = (sb >> 4) & 7; R = st * 8 + row; C = ((chs ^ ((R >> 1) & 7)) << 3) + ((sb & 15) >> 1); }
#else
__host__ __device__ __forceinline__ int lds_byte(int r, int c) { const int st = (r >> 4) * 2 + (c >> 5), rr = r & 15, cc = c & 31, ob = rr * 64 + cc * 2; return st * 1024 + (ob ^ (((ob >> 9) & 1) << 5)); }
__host__ __device__ __forceinline__ void stage_rc(int b, int& R, int& C) { const int st = b / 1024, sb = b % 1024, swz = sb ^ (((sb >> 9) & 1) << 5); R = (st >> 1) * 16 + swz / 64; C = (st & 1) * 32 + (swz % 64) / 2; }
#endif
__host__ __device__ __forceinline__ int perm32(int rho) { const int n = rho >> 4, i = rho & 15; return 8 * (i >> 2) + 4 * n + (i & 3); }

struct Unit { int pm, pn, hm; };
struct Gemm { const bf16_t* A; const bf16_t* Bt; int lda; int K; int N; int a_pn_cols; };

struct StaticOrder {
    int nM, nN, nwg, G, c;
    __device__ void init(int M_, int N_, int G_, int c_) { nM = M_ / BM; nN = N_ / BM; nwg = nM * nN; G = G_; c = c_; }
    __device__ bool next(int i, Unit& u) const {
        const long L = (long)i * G + c; if (L >= nwg) return false;
        int wgid = (int)L; { const int q = nwg / NXCD, r = nwg % NXCD, xcd = wgid % NXCD, off = wgid / NXCD; wgid = (xcd < r ? xcd * (q + 1) : r * (q + 1) + (xcd - r) * q) + off; }
        const int nig = WGM * nN, gid = wgid / nig, fm = gid * WGM, gsz = (nM - fm) < WGM ? (nM - fm) : WGM;
        u.pm = fm + ((wgid % nig) % gsz); u.pn = (wgid % nig) / gsz; u.hm = -1; return true;
    }
};
struct TailHalfOrder : StaticOrder {
    __device__ bool next(int i, Unit& u) const {
        const int full = nwg / G;
        if (i < full || 2 * (nwg % G) != G) return StaticOrder::next(i, u);
        if (i > full) return false;
        const int xcd = c % NXCD, k = c / NXCD, off = full * (G / NXCD) + (k >> 1);
        const int q = nwg / NXCD; int wgid = xcd * q + off;
        const int nig = WGM * nN, gid = wgid / nig, fm = gid * WGM, gsz = (nM - fm) < WGM ? (nM - fm) : WGM;
        u.pm = fm + ((wgid % nig) % gsz); u.pn = (wgid % nig) / gsz; u.hm = k & 1; return true;
    }
};

struct EpiResid {
    static constexpr bool PERM = true;
    static constexpr bool ACC_INIT = true;
    const bf16_t* XB; bf16_t* XBo; float* SS;
    float* fout; const float* gfin; float* slots; unsigned* cnt; int tid;
    __device__ __forceinline__ void operator()(const f32x4 (&acc)[2][2][4][2], const Unit& u, int wr, int wc, int fr, int fq) const {
        if (fout) { final_fused(acc, u, wr, wc, fr, fq); return; }
#pragma unroll
        for (int ai = 0; ai < 2; ++ai) rows(acc[ai], u, ai, wr, wc, fr, fq);
    }
    __device__ __forceinline__ void final_fused(const f32x4 (&acc)[2][2][4][2], const Unit& u, int wr, int wc, int fr, int fq) const {
        const int col0 = u.pn * BM + wc * 32 + 8 * fq;
        PG8_LAS float* P = (PG8_LAS float*)(131072 + 8192);
        PG8_LAS float* R = (PG8_LAS float*)(131072 + 8192 + 4096);
#pragma unroll
        for (int ai = 0; ai < 2; ++ai)
#pragma unroll
            for (int m = 0; m < 4; ++m) { const int rl = ai * HALF + wr * 64 + m * 16 + fr; const size_t off = (size_t)(u.pm * BM + rl) * D + col0; float ssq = 0.f;
#pragma unroll
                for (int bj = 0; bj < 2; ++bj) { const f32x4 a0 = acc[ai][bj][m][0], a1 = acc[ai][bj][m][1];
                    const float v0 = a0.x, v1 = a0.y, v2 = a0.z, v3 = a0.w, v4 = a1.x, v5 = a1.y, v6 = a1.z, v7 = a1.w;
                    ssq += ((v0 * v0 + v1 * v1) + (v2 * v2 + v3 * v3)) + ((v4 * v4 + v5 * v5) + (v6 * v6 + v7 * v7)); }
                ssq = xor32_sum(xor16_sum(ssq));
                if (fq == 0) P[rl * 4 + wc] = ssq; }
        asm volatile("s_waitcnt lgkmcnt(0)" ::: "memory"); __builtin_amdgcn_s_barrier(); asm volatile("" ::: "memory");
        if (tid < 256) { const float s = (P[tid * 4] + P[tid * 4 + 1]) + (P[tid * 4 + 2] + P[tid * 4 + 3]);
            __hip_atomic_store(slots + (size_t)(u.pm * BM + tid) * 4 + u.pn, s, __ATOMIC_RELAXED, __HIP_MEMORY_SCOPE_AGENT); }
        asm volatile("s_waitcnt vmcnt(0)" ::: "memory"); __builtin_amdgcn_s_barrier(); asm volatile("" ::: "memory");
        if (tid == 0) __hip_atomic_fetch_add(cnt + 64 * u.pm, 1u, __ATOMIC_RELAXED, __HIP_MEMORY_SCOPE_AGENT);
        if (tid < 64) { unsigned spins = 0;
            while ((unsigned)__builtin_amdgcn_readfirstlane((int)__hip_atomic_load(cnt + 64 * u.pm, __ATOMIC_RELAXED, __HIP_MEMORY_SCOPE_AGENT)) < 4u) { __builtin_amdgcn_s_sleep(2); if (++spins > (1u << 22)) break; } }
        asm volatile("s_waitcnt vmcnt(0) lgkmcnt(0)" ::: "memory"); __builtin_amdgcn_s_barrier(); asm volatile("" ::: "memory");
        if (tid < 256) { const float* sl = slots + (size_t)(u.pm * BM + tid) * 4; float s = 0.f;
#pragma unroll
            for (int t = 0; t < 4; ++t) s += __hip_atomic_load(sl + t, __ATOMIC_RELAXED, __HIP_MEMORY_SCOPE_AGENT);
            R[tid] = 1.0f / sqrtf(s * (1.0f / D) + EPS); }
        asm volatile("s_waitcnt vmcnt(0) lgkmcnt(0)" ::: "memory"); __builtin_amdgcn_s_barrier(); asm volatile("" ::: "memory");
        f32x4 g4[2][2];
#pragma unroll
        for (int bj = 0; bj < 2; ++bj) { g4[bj][0] = *(const f32x4*)(gfin + col0 + bj * HALF); g4[bj][1] = *(const f32x4*)(gfin + col0 + bj * HALF + 4); }
#pragma unroll
        for (int ai = 0; ai < 2; ++ai)
#pragma unroll
            for (int m = 0; m < 4; ++m) { const int rl = ai * HALF + wr * 64 + m * 16 + fr; const size_t off = (size_t)(u.pm * BM + rl) * D + col0; const float rs = R[rl];
#pragma unroll
                for (int bj = 0; bj < 2; ++bj) { const f32x4 o0 = acc[ai][bj][m][0] * rs, o1 = acc[ai][bj][m][1] * rs;
                    __builtin_nontemporal_store(o0 * g4[bj][0], (f32x4*)(fout + off + bj * HALF)); __builtin_nontemporal_store(o1 * g4[bj][1], (f32x4*)(fout + off + bj * HALF + 4)); } }
    }
    __device__ __forceinline__ void load_q(u32x4 (&xr)[4], const Unit& u, int ai, int bj, int wr, int wc, int fr, int fq) const {
        const int col0 = u.pn * BM + wc * 32 + 8 * fq + bj * HALF;
#pragma unroll
        for (int m = 0; m < 4; ++m) xr[m] = *(const u32x4*)(XB + (size_t)(u.pm * BM + ai * HALF + wr * 64 + m * 16 + fr) * D + col0);
    }
    static __device__ __forceinline__ void cvt_q(f32x4 (&a)[4][2], const u32x4 (&xr)[4]) {
#pragma unroll
        for (int m = 0; m < 4; ++m) { const u32x4 b = xr[m]; a[m][0] = (f32x4){bf_lo(b.x), bf_hi(b.x), bf_lo(b.y), bf_hi(b.y)}; a[m][1] = (f32x4){bf_lo(b.z), bf_hi(b.z), bf_lo(b.w), bf_hi(b.w)}; }
    }
    __device__ __forceinline__ void rows(const f32x4 (&a)[2][4][2], const Unit& u, int ai, int wr, int wc, int fr, int fq) const {
        const int col0 = u.pn * BM + wc * 32 + 8 * fq;
#pragma unroll
        for (int m = 0; m < 4; ++m) { const int row = u.pm * BM + ai * HALF + wr * 64 + m * 16 + fr; const size_t off = (size_t)row * D + col0; float ssq = 0.f;
#pragma unroll
            for (int bj = 0; bj < 2; ++bj) {
                const f32x4 a0 = a[bj][m][0], a1 = a[bj][m][1];
                u32x4 w; w.x = cvtpk(a0.x, a0.y); w.y = cvtpk(a0.z, a0.w); w.z = cvtpk(a1.x, a1.y); w.w = cvtpk(a1.z, a1.w);
                *(u32x4*)(XBo + off + bj * HALF) = w;
                const float r0 = bf_lo(w.x), r1 = bf_hi(w.x), r2 = bf_lo(w.y), r3 = bf_hi(w.y), r4 = bf_lo(w.z), r5 = bf_hi(w.z), r6 = bf_lo(w.w), r7 = bf_hi(w.w);
                ssq += ((r0 * r0 + r1 * r1) + (r2 * r2 + r3 * r3)) + ((r4 * r4 + r5 * r5) + (r6 * r6 + r7 * r7)); }
            ssq = xor32_sum(xor16_sum(ssq));
            if (fq == 0) SS[(size_t)row * 16 + u.pn * 4 + wc] = ssq; }
    }
};
constexpr int RSTD_TAB_OFF = 131072 + 4096, RSTD_TAG_OFF = RSTD_TAB_OFF + 1024;
__device__ __forceinline__ const PG8_LAS float* rstd_table(const float* SS, int pm, int tid) {
    PG8_LAS float* tab = (PG8_LAS float*)(RSTD_TAB_OFF); volatile PG8_LAS int* tag = (volatile PG8_LAS int*)(RSTD_TAG_OFF);
    if (*tag == pm) return tab;
    if (tid < 256) tab[tid] = row_rstd(SS, pm * BM + tid);
    asm volatile("s_waitcnt lgkmcnt(0)" ::: "memory"); __builtin_amdgcn_s_barrier(); asm volatile("" ::: "memory");
    if (tid == 0) *tag = pm;
    return tab;
}
__device__ __forceinline__ void rstd_table_reset(int tid) { if (tid == 0) *(volatile PG8_LAS int*)(RSTD_TAG_OFF) = -1; }
struct EpiSwiglu {
    static constexpr bool PERM = true; static constexpr bool ACC_INIT = false;
    bf16_t* ACT; const float* SS; int tid; int skip;
    __device__ __forceinline__ void operator()(const f32x4 (&acc)[2][2][4][2], const Unit& u, int wr, int wc, int fr, int fq) const {
        if (skip && SS[0] != 123456.75f) return;
        const int col0 = u.pn * HALF + wc * 32 + 8 * fq;
        const PG8_LAS float* tab = rstd_table(SS, u.pm, tid);
        const int nai = u.hm < 0 ? 2 : 1, rb = u.hm < 0 ? 0 : u.hm * HALF;
#pragma unroll
        for (int ai = 0; ai < 2; ++ai) if (ai < nai)
#pragma unroll
            for (int m = 0; m < 4; ++m) { const int rl = rb + ai * HALF + wr * 64 + m * 16 + fr, row = u.pm * BM + rl; const float rs = tab[rl];
                const f32x4 g0 = acc[ai][0][m][0] * rs, g1 = acc[ai][0][m][1] * rs, u0 = acc[ai][1][m][0] * rs, u1 = acc[ai][1][m][1] * rs;
                const f32x4 x0 = g0 * -LOG2E, x1 = g1 * -LOG2E;
                f32x4 e0, e1; e0.x = __builtin_amdgcn_exp2f(x0.x); e0.y = __builtin_amdgcn_exp2f(x0.y); e0.z = __builtin_amdgcn_exp2f(x0.z); e0.w = __builtin_amdgcn_exp2f(x0.w);
                e1.x = __builtin_amdgcn_exp2f(x1.x); e1.y = __builtin_amdgcn_exp2f(x1.y); e1.z = __builtin_amdgcn_exp2f(x1.z); e1.w = __builtin_amdgcn_exp2f(x1.w);
                const f32x4 d0 = e0 + 1.0f, d1 = e1 + 1.0f;
                f32x4 r0, r1; r0.x = __builtin_amdgcn_rcpf(d0.x); r0.y = __builtin_amdgcn_rcpf(d0.y); r0.z = __builtin_amdgcn_rcpf(d0.z); r0.w = __builtin_amdgcn_rcpf(d0.w);
                r1.x = __builtin_amdgcn_rcpf(d1.x); r1.y = __builtin_amdgcn_rcpf(d1.y); r1.z = __builtin_amdgcn_rcpf(d1.z); r1.w = __builtin_amdgcn_rcpf(d1.w);
                const f32x4 o0 = (g0 * u0) * r0, o1 = (g1 * u1) * r1;
                u32x4 w; w.x = cvtpk(o0.x, o0.y); w.y = cvtpk(o0.z, o0.w); w.z = cvtpk(o1.x, o1.y); w.w = cvtpk(o1.z, o1.w);
                st16_wt(ACT + (size_t)row * DFF + col0, w); }
    }
};
struct EpiKVQ {
    static constexpr bool PERM = true; static constexpr bool ACC_INIT = false;
    bf16_t* Kb; bf16_t* Qb; float* KMP; const float* SS; int pn_off; int tid;
    __device__ __forceinline__ void operator()(const f32x4 (&acc)[2][2][4][2], const Unit& u, int wr, int wc, int fr, int fq) const {
        const int tile = u.pn + pn_off, t = tile >> 2, col0 = (tile & 3) * BM + wc * 32 + 8 * fq;
        const PG8_LAS float* tab = rstd_table(SS, u.pm, tid);
        bf16_t* dst = (t == 2) ? Qb : Kb + (size_t)t * ((size_t)M * D);
#pragma unroll
        for (int ai = 0; ai < 2; ++ai) {
            f32x4 cs[2][2];
#pragma unroll
            for (int bj = 0; bj < 2; ++bj)
#pragma unroll
                for (int n = 0; n < 2; ++n) cs[bj][n] = (f32x4){0.f, 0.f, 0.f, 0.f};
#pragma unroll
            for (int m = 0; m < 4; ++m) { const int rl = ai * HALF + wr * 64 + m * 16 + fr, row = u.pm * BM + rl; const float rs = tab[rl];
#pragma unroll
                for (int bj = 0; bj < 2; ++bj) { const f32x4 v0 = acc[ai][bj][m][0] * rs, v1 = acc[ai][bj][m][1] * rs; cs[bj][0] = cs[bj][0] + v0; cs[bj][1] = cs[bj][1] + v1;
                    u32x4 w; w.x = cvtpk(v0.x, v0.y); w.y = cvtpk(v0.z, v0.w); w.z = cvtpk(v1.x, v1.y); w.w = cvtpk(v1.z, v1.w);
                    *(u32x4*)(dst + (size_t)row * D + col0 + bj * HALF) = w; } }
            if (t == 0) {
#pragma unroll
                for (int bj = 0; bj < 2; ++bj)
#pragma unroll
                    for (int n = 0; n < 2; ++n) { f32x4 c = cs[bj][n];
                        c.x = row16_sum(c.x); c.y = row16_sum(c.y); c.z = row16_sum(c.z); c.w = row16_sum(c.w);
                        if (fr == 0) *(f32x4*)(KMP + ((size_t)u.pm * 4 + 2 * ai + wr) * D + col0 + bj * HALF + 4 * n) = c; }
            }
        }
    }
};

template <class Epi, class Sched>
__device__ __forceinline__ void gemm_phase(PG8_LAS unsigned char* lds, const Gemm g, const Sched& S, const Epi& E, const int tid) {
    const int wid = __builtin_amdgcn_readfirstlane(tid >> 6), lane = tid & 63, wr = wid >> 2, wc = wid & 3, fr = lane & 15, fq = lane >> 4;
    const int K = g.K, nt = K / BK, lda = g.lda;
    unsigned voffA[2], voffB[2];
#pragma unroll
    for (int i = 0; i < 2; ++i) { int R, C; stage_rc(tid * 16 + i * 8192, R, C); const int Rb = Epi::PERM ? ((R & ~31) + perm32(R & 31)) : R;
        voffA[i] = (unsigned)(R * lda + C) * 2u; voffB[i] = (unsigned)(Rb * K + C) * 2u; }
    const size_t kstep = (size_t)(BK * 2);
    const size_t hstepA = (size_t)HALF * lda * 2, hstepB = (size_t)HALF * K * 2;
    const size_t tstepA = 2 * hstepA, tstepB = 2 * hstepB;
    const size_t pnA = (size_t)g.a_pn_cols * 2;
    const unsigned ldsw = (unsigned)wid * 1024u;
    const int aoff[2] = {lds_byte(wr * 64 + fr, fq * 8), lds_byte(wr * 64 + fr, fq * 8 + 32)}, boff[2] = {lds_byte(wc * 32 + fr, fq * 8), lds_byte(wc * 32 + fr, fq * 8 + 32)};
#define PG8_SA(b, h) (((b) * 2 + (h)) * HTB)
#define PG8_SB(b, h) ((4 + (b) * 2 + (h)) * HTB)
#define PG8_STAGE(bufoff, gbase, voff) do { _Pragma("unroll") for (int _i = 0; _i < 2; ++_i) \
        __builtin_amdgcn_global_load_lds((const unsigned*)((const char*)(gbase) + (voff)[_i]), (PG8_LAS unsigned*)(lds + (bufoff) + ldsw + _i * 8192), 16, 0, 0); } while (0)
#define PG8_LDA(dst, b, h) do { _Pragma("unroll") for (int m = 0; m < 4; ++m) _Pragma("unroll") for (int k = 0; k < 2; ++k) dst[m][k] = *(const PG8_LAS bf16x8*)(lds + PG8_SA(b, h) + aoff[k] + m * 2048); } while (0)
#define PG8_LDB(dst, b, h) do { _Pragma("unroll") for (int n = 0; n < 2; ++n) _Pragma("unroll") for (int k = 0; k < 2; ++k) dst[n][k] = *(const PG8_LAS bf16x8*)(lds + PG8_SB(b, h) + boff[k] + n * 2048); } while (0)
#define PG8_MMA(ai, bj, At, Bt) do { __builtin_amdgcn_s_setprio(1); _Pragma("unroll") for (int m = 0; m < 4; ++m) _Pragma("unroll") for (int n = 0; n < 2; ++n) _Pragma("unroll") for (int k = 0; k < 2; ++k) \
        acc[ai][bj][m][n] = __builtin_amdgcn_mfma_f32_16x16x32_bf16(Bt[n][k], At[m][k], acc[ai][bj][m][n], 0, 0, 0); __builtin_amdgcn_s_setprio(0); } while (0)
#define PG8_WAIT_V(n) asm volatile("s_waitcnt vmcnt(" #n ")" ::: "memory")
#define PG8_WAIT_L(n) asm volatile("s_waitcnt lgkmcnt(" #n ")" ::: "memory")
#define PG8_BAR __builtin_amdgcn_s_barrier()
#define PG8_SCHED __builtin_amdgcn_sched_barrier(0)
    Unit cur, nxt; int ui = 0;
    if (!S.next(0, cur)) return;
    f32x4 acc[2][2][4][2];
    u32x4 xr[2][2][4];
    if constexpr (Epi::ACC_INIT) {
#pragma unroll
        for (int a = 0; a < 2; ++a)
#pragma unroll
            for (int b = 0; b < 2; ++b) E.load_q(xr[a][b], cur, a, b, wr, wc, fr, fq);
        PG8_SCHED;
    } else {
#pragma unroll
    for (int a = 0; a < 2; ++a)
#pragma unroll
        for (int b = 0; b < 2; ++b)
#pragma unroll
            for (int m = 0; m < 4; ++m)
#pragma unroll
                for (int n = 0; n < 2; ++n) acc[a][b][m][n] = (f32x4){0.f, 0.f, 0.f, 0.f};
    }
    bf16x8 At[4][2], B0[2][2], B1[2][2];
    const char* cA = (const char*)g.A + (size_t)cur.pm * tstepA + (size_t)cur.pn * pnA + (cur.hm > 0 ? hstepA : 0); const char* cB = (const char*)g.Bt + (size_t)cur.pn * tstepB;
    size_t chs = cur.hm < 0 ? hstepA : 0;
    PG8_STAGE(PG8_SB(0, 0), cB, voffB); PG8_STAGE(PG8_SB(0, 1), cB + hstepB, voffB); PG8_STAGE(PG8_SA(0, 0), cA, voffA); PG8_STAGE(PG8_SA(0, 1), cA + chs, voffA);
    if (wr == 1) PG8_BAR;
    PG8_WAIT_V(2); PG8_BAR;
    PG8_STAGE(PG8_SB(1, 0), cB + kstep, voffB); PG8_STAGE(PG8_SA(1, 0), cA + kstep, voffA); PG8_STAGE(PG8_SB(1, 1), cB + hstepB + kstep, voffB);
    PG8_WAIT_V(6); PG8_BAR;
    if constexpr (Epi::ACC_INIT) {
#pragma unroll
        for (int a = 0; a < 2; ++a)
#pragma unroll
            for (int b = 0; b < 2; ++b) Epi::cvt_q(acc[a][b], xr[a][b]);
        PG8_SCHED;
    }
    for (;;) {
        const bool has_next = S.next(ui + 1, nxt);
        const char* nA = has_next ? (const char*)g.A + (size_t)nxt.pm * tstepA + (size_t)nxt.pn * pnA + (nxt.hm > 0 ? hstepA : 0) : cA; const char* nB = has_next ? (const char*)g.Bt + (size_t)nxt.pn * tstepB : cB;
        const size_t nhs = has_next ? (nxt.hm < 0 ? hstepA : 0) : chs; const bool fullu = cur.hm < 0;
        for (int t = 0; t < nt; t += 2) {
            const bool last = (t == nt - 2);
            const char* a1 = cA + (size_t)(t + 1) * kstep;
            const char* a2 = last ? nA : cA + (size_t)(t + 2) * kstep; const char* b2 = last ? nB : cB + (size_t)(t + 2) * kstep;
            const char* a3 = a2 + kstep; const char* b3 = b2 + kstep;
            PG8_LDB(B0, 0, 0); PG8_LDB(B1, 0, 1); PG8_SCHED; PG8_LDA(At, 0, 0); PG8_STAGE(PG8_SA(1, 1), a1 + chs, voffA);
            PG8_WAIT_V(8); PG8_WAIT_L(0); PG8_BAR; PG8_MMA(0, 0, At, B0); PG8_MMA(0, 1, At, B1); PG8_BAR; PG8_SCHED;
            PG8_LDA(At, 0, 1); PG8_STAGE(PG8_SB(0, 0), b2, voffB); PG8_STAGE(PG8_SB(0, 1), b2 + hstepB, voffB); PG8_STAGE(PG8_SA(0, 0), a2, voffA);
            PG8_WAIT_V(8); PG8_WAIT_L(0); PG8_BAR; if (fullu) { PG8_MMA(1, 0, At, B0); PG8_MMA(1, 1, At, B1); } PG8_BAR; PG8_SCHED;
            PG8_LDB(B0, 1, 0); PG8_LDB(B1, 1, 1); PG8_SCHED; PG8_LDA(At, 1, 0); PG8_STAGE(PG8_SA(0, 1), a2 + (last ? nhs : chs), voffA);
            PG8_WAIT_V(8); PG8_WAIT_L(0); PG8_BAR; PG8_MMA(0, 0, At, B0); PG8_MMA(0, 1, At, B1); PG8_BAR; PG8_SCHED;
            PG8_LDA(At, 1, 1); PG8_STAGE(PG8_SB(1, 0), b3, voffB); PG8_STAGE(PG8_SB(1, 1), b3 + hstepB, voffB); PG8_STAGE(PG8_SA(1, 0), a3, voffA);
            PG8_WAIT_V(8); PG8_WAIT_L(0); PG8_BAR; if (fullu) { PG8_MMA(1, 0, At, B0); PG8_MMA(1, 1, At, B1); } PG8_BAR; PG8_SCHED;
        }
        if (wr == 0) PG8_BAR;
        E(acc, cur, wr, wc, fr, fq);
        if (!has_next) break;
        if constexpr (Epi::ACC_INIT) {
#pragma unroll
            for (int a = 0; a < 2; ++a)
#pragma unroll
                for (int b = 0; b < 2; ++b) { E.load_q(xr[a][b], nxt, a, b, wr, wc, fr, fq); Epi::cvt_q(acc[a][b], xr[a][b]); }
        } else {
#pragma unroll
        for (int a = 0; a < 2; ++a)
#pragma unroll
            for (int b = 0; b < 2; ++b)
#pragma unroll
                for (int m = 0; m < 4; ++m)
#pragma unroll
                    for (int n = 0; n < 2; ++n) acc[a][b][m][n] = (f32x4){0.f, 0.f, 0.f, 0.f};
        }
        cur = nxt; cA = nA; cB = nB; chs = nhs; ++ui;
        if (wr == 1) PG8_BAR;
    }
    PG8_WAIT_V(0);
    PG8_BAR;
#undef PG8_SA
#undef PG8_SB
#undef PG8_STAGE
#undef PG8_LDA
#undef PG8_LDB
#undef PG8_MMA
#undef PG8_WAIT_V
#undef PG8_WAIT_L
#undef PG8_BAR
#undef PG8_SCHED
}
}
namespace poolf {
using namespace pg8;
template <int W> __device__ __forceinline__ void build_d(PG8_LAS unsigned char* lds, const bf16_t* X, const float* SS, int pm, int g, int ai, int wid, int lane) {
    constexpr int NR = 16 + W - 1;
    const int hw = lane >> 5, l32 = lane & 31;
    const int bq = pm >> 3, t0 = (pm & 7) * 256 + 128 * ai + 16 * wid;
    const int c0 = 256 * g + 128 * hw + 4 * l32;
    float rs = 0.f; { const int t = t0 - (W - 1) + l32; if (l32 < NR && t >= 0) rs = row_rstd(SS, bq * SEQ + t); }
    f32x4 v[NR]; u32x2 wraw[NR];
#pragma unroll
    for (int i = 0; i < NR; ++i) { const int t = t0 - (W - 1) + i, tc = t < 0 ? 0 : t;
        wraw[i] = *(const u32x2*)(X + (size_t)(bq * SEQ + tc) * D + c0); }
    __builtin_amdgcn_sched_barrier(0);
#pragma unroll
    for (int i = 0; i < NR; ++i) { const float r = lane_bcast(rs, i); v[i] = (f32x4){bf_lo(wraw[i].x), bf_hi(wraw[i].x), bf_lo(wraw[i].y), bf_hi(wraw[i].y)} * r; }
    f32x4 S = (f32x4){0.f, 0.f, 0.f, 0.f};
#pragma unroll
    for (int i = 0; i < W - 1; ++i) S = S + v[i];
    const int kt = 2 * hw + (l32 >> 4), cc = (4 * l32) & 63;
#pragma unroll
    for (int r = 0; r < 16; ++r) { const int i = r + W - 1; S = S + v[i]; const int t = t0 + r; const float cnt = (float)((t + 1) < W ? (t + 1) : W);
        const f32x4 d = S * __builtin_amdgcn_rcpf(cnt) - v[i];     u32x2 w; w.x = cvtpk(d.x, d.y); w.y = cvtpk(d.z, d.w);
        *(PG8_LAS u32x2*)(lds + kt * HTB + lds_byte(16 * wid + r, cc)) = w; S = S - v[r]; }
}
__device__ __forceinline__ void build_d_dispatch(PG8_LAS unsigned char* lds, const bf16_t* X, const float* SS, int pm, int g, int ai, int wid, int lane) {
    if (g == 0) build_d<2>(lds, X, SS, pm, 0, ai, wid, lane); else if (g == 1) build_d<4>(lds, X, SS, pm, 1, ai, wid, lane);
    else if (g == 2) build_d<8>(lds, X, SS, pm, 2, ai, wid, lane); else build_d<16>(lds, X, SS, pm, 3, ai, wid, lane);
}
__device__ __forceinline__ void pool_phase(PG8_LAS unsigned char* lds, const bf16_t* XB, const float* SS, const bf16_t* Wp, const StaticOrder& S, const EpiResid& E, const int tid) {
    const int wid = __builtin_amdgcn_readfirstlane(tid >> 6), lane0 = tid & 63, wr = wid >> 2, wc = wid & 3;
    constexpr int K = 256;
    const unsigned ldsw = (unsigned)wid * 1024u;
    Unit u;
    for (int ui = 0; S.next(ui, u); ++ui) {
        const char* cB = (const char*)Wp + (size_t)u.pn * 256 * K * 2;
        for (int ai = 0; ai < 2; ++ai) {
            int lane = lane0; asm volatile("" : "+v"(lane)); const int fr = lane & 15, fq = lane >> 4, tidl = wid * 64 + lane;
            unsigned voffB[2];
#pragma unroll
            for (int i = 0; i < 2; ++i) { int R, C; stage_rc(tidl * 16 + i * 8192, R, C); const int Rb = (R & ~31) + perm32(R & 31); voffB[i] = (unsigned)(Rb * K + C) * 2u; }
#pragma unroll
            for (int kt = 0; kt < 4; ++kt)
#pragma unroll
                for (int i = 0; i < 2; ++i)
                    __builtin_amdgcn_global_load_lds((const unsigned*)(cB + (size_t)kt * (BK * 2) + voffB[i]), (PG8_LAS unsigned*)(lds + (4 + kt) * HTB + ldsw + i * 8192), 16, 0, 0);
            build_d_dispatch(lds, XB, SS, u.pm, u.pn, ai, wid, lane);
            const int aoff[2] = {lds_byte(wr * 64 + fr, fq * 8), lds_byte(wr * 64 + fr, fq * 8 + 32)}, boff[2] = {lds_byte(wc * 32 + fr, fq * 8), lds_byte(wc * 32 + fr, fq * 8 + 32)};
            f32x4 acc[2][4][2];
#pragma unroll
            for (int bj = 0; bj < 2; ++bj) {
                if (bj == 1) {
#pragma unroll
                    for (int kt = 0; kt < 4; ++kt)
#pragma unroll
                        for (int i = 0; i < 2; ++i)
                            __builtin_amdgcn_global_load_lds((const unsigned*)(cB + (size_t)HALF * K * 2 + (size_t)kt * (BK * 2) + voffB[i]), (PG8_LAS unsigned*)(lds + (4 + kt) * HTB + ldsw + i * 8192), 16, 0, 0);
                }
                u32x4 xr[4]; E.load_q(xr, u, ai, bj, wr, wc, fr, fq);
                asm volatile("s_waitcnt vmcnt(0) lgkmcnt(0)" ::: "memory"); __builtin_amdgcn_s_barrier(); asm volatile("" ::: "memory");
                EpiResid::cvt_q(acc[bj], xr);
#pragma unroll
                for (int kt = 0; kt < 4; ++kt) {
                    bf16x8 At[4][2], Bt[2][2];
#pragma unroll
                    for (int n = 0; n < 2; ++n)
#pragma unroll
                        for (int k = 0; k < 2; ++k) Bt[n][k] = *(const PG8_LAS bf16x8*)(lds + (4 + kt) * HTB + boff[k] + n * 2048);
#pragma unroll
                    for (int m = 0; m < 4; ++m)
#pragma unroll
                        for (int k = 0; k < 2; ++k) At[m][k] = *(const PG8_LAS bf16x8*)(lds + kt * HTB + aoff[k] + m * 2048);
#pragma unroll
                    for (int m = 0; m < 4; ++m)
#pragma unroll
                        for (int n = 0; n < 2; ++n)
#pragma unroll
                            for (int k = 0; k < 2; ++k) acc[bj][m][n] = __builtin_amdgcn_mfma_f32_16x16x32_bf16(Bt[n][k], At[m][k], acc[bj][m][n], 0, 0, 0);
                }
                asm volatile("s_waitcnt lgkmcnt(0)" ::: "memory"); __builtin_amdgcn_s_barrier(); asm volatile("" ::: "memory");
            }
            E.rows(acc, u, ai, wr, wc, fr, fq);
        }
    }
}
}
#include <hip/hip_bf16.h>
#include <cmath>
namespace attn_body {
using bf16=__hip_bfloat16;
using bf16x8=__attribute__((ext_vector_type(8)))short;
using s16x4=__attribute__((ext_vector_type(4)))short;
using f32x16=__attribute__((ext_vector_type(16)))float;
using u32x4=__attribute__((ext_vector_type(4)))unsigned;
using f32x4=__attribute__((ext_vector_type(4)))float;
constexpr int NHEAD=16,SEQ=2048,D=64,DM=NHEAD*D;
constexpr int NW=8,QBLK=32,QB=QBLK*NW,KVBLK=64;
__device__ __forceinline__ int crow(int r,int hi){return (r&3)+8*(r>>2)+4*hi;}
#define SBAR() __builtin_amdgcn_sched_barrier(0)
typedef __attribute__((address_space(3))) const float* lds_fptr;
__device__ __forceinline__ void bias_load(f32x16&b0,f32x16&b1,int dl,int hi,lds_fptr bt){
  const lds_fptr pb=bt+(dl-4*hi+69);
  #pragma unroll
  for(int r=0;r<16;++r){ const int c=(r&3)+8*(r>>2); b0[r]=pb[59-c]; b1[r]=pb[27-c]; }
}

constexpr int NSLOT=3, SLOTB=8192;
constexpr int LDS_K=0, LDS_V=NSLOT*SLOTB, LDS_WS=2*NSLOT*SLOTB, LDS_OST=LDS_WS+NW*64*4, LDS_BT=LDS_OST+NW*4096, LDS_KM=LDS_BT+2560, LDS_QP=LDS_KM+2048, LDS_BYTES=LDS_QP+4*8192;
__device__ __forceinline__ void glds16(const void*sbase,unsigned voff,unsigned lds_dst){unsigned keep;
  asm volatile("s_mov_b32 %0, m0\n\ts_mov_b32 m0, %3\n\ts_nop 0\n\tglobal_load_lds_dwordx4 %1, %2\n\ts_mov_b32 m0, %0":"=&s"(keep):"v"(voff),"s"(sbase),"s"(lds_dst):"memory");}
__device__ __forceinline__ float max3f(float a,float b,float c){float r;asm("v_max3_f32 %0, %1, %2, %3":"=v"(r):"v"(a),"v"(b),"v"(c));return r;}
__device__ __forceinline__ float max2f(float a,float b){float r;asm("v_max_f32_e32 %0, %1, %2":"=v"(r):"v"(a),"v"(b));return r;}
__device__ __forceinline__ float fadd_s(float a,float b){float r;asm("v_add_f32_e32 %0, %1, %2":"=v"(r):"v"(a),"v"(b));return r;}
__device__ __forceinline__ float fsub_s(float a,float b){float r;asm("v_sub_f32_e32 %0, %1, %2":"=v"(r):"v"(a),"v"(b));return r;}
typedef float f32x2_t __attribute__((ext_vector_type(2))); typedef __bf16 bf16x2_t __attribute__((ext_vector_type(2)));
__device__ __forceinline__ unsigned cvtpk_s(float lo,float hi){f32x2_t v={lo,hi};bf16x2_t b=__builtin_convertvector(v,bf16x2_t);return __builtin_bit_cast(unsigned,b);}
#define WAIT_BAR(N) asm volatile("s_waitcnt vmcnt(" #N ") lgkmcnt(0)\n\ts_barrier":::"memory")

__device__ __forceinline__ void qkt(f32x16&p0,f32x16&p1,const char*Kslot,const bf16x8*qr,const f32x16 i0,const f32x16 i1,int r32,int hi){
  const char*kb=Kslot+hi*1024+r32*16;
  #pragma unroll
  for(int d0=0;d0<4;++d0){
    const bf16x8 b0=*reinterpret_cast<const bf16x8*>(kb+d0*2048);
    const bf16x8 b1=*reinterpret_cast<const bf16x8*>(kb+d0*2048+512);
    if(d0==0){p0=__builtin_amdgcn_mfma_f32_32x32x16_bf16(b0,qr[0],i0,0,0,0);p1=__builtin_amdgcn_mfma_f32_32x32x16_bf16(b1,qr[0],i1,0,0,0);}
    else{p0=__builtin_amdgcn_mfma_f32_32x32x16_bf16(b0,qr[d0],p0,0,0,0);p1=__builtin_amdgcn_mfma_f32_32x32x16_bf16(b1,qr[d0],p1,0,0,0);}}
}
typedef __attribute__((address_space(3))) const char* lds_cptr;
typedef short v4i16_t __attribute__((ext_vector_type(4)));
__device__ __forceinline__ void kload8(bf16x8*kf,lds_cptr kp){
  kf[0]=*(const __attribute__((address_space(3))) bf16x8*)(kp);      kf[1]=*(const __attribute__((address_space(3))) bf16x8*)(kp+512);
  kf[2]=*(const __attribute__((address_space(3))) bf16x8*)(kp+2048); kf[3]=*(const __attribute__((address_space(3))) bf16x8*)(kp+2560);
  kf[4]=*(const __attribute__((address_space(3))) bf16x8*)(kp+4096); kf[5]=*(const __attribute__((address_space(3))) bf16x8*)(kp+4608);
  kf[6]=*(const __attribute__((address_space(3))) bf16x8*)(kp+6144); kf[7]=*(const __attribute__((address_space(3))) bf16x8*)(kp+6656);
}
__device__ __forceinline__ void kload2(bf16x8*kf,lds_cptr kp,int j){ kf[2*j]=*(const __attribute__((address_space(3))) bf16x8*)(kp+j*2048); kf[2*j+1]=*(const __attribute__((address_space(3))) bf16x8*)(kp+j*2048+512); }
__device__ __forceinline__ s16x4 vtr(lds_cptr p){ return __builtin_bit_cast(s16x4,__builtin_amdgcn_ds_read_tr16_b64_v4i16((__attribute__((address_space(3))) v4i16_t*)p)); }
__device__ __forceinline__ float rowmax(const f32x16&p0,const f32x16&p1){
  float a=max3f(p0[0],p0[1],p1[0]),b=max3f(p0[2],p0[3],p1[1]);a=max3f(a,p1[2],p1[3]);
  #pragma unroll
  for(int r=4;r<16;r+=4){a=max3f(a,p0[r],p0[r+1]);b=max3f(b,p0[r+2],p0[r+3]);a=max3f(a,p1[r],p1[r+1]);b=max3f(b,p1[r+2],p1[r+3]);}
  const float m=max2f(a,b);
  auto rr=__builtin_amdgcn_permlane32_swap(__float_as_uint(m),__float_as_uint(m),false,false);
  return max2f(__uint_as_float(rr[0]),__uint_as_float(rr[1]));
}
__device__ __forceinline__ void pv(f32x16*o,int vb,bf16x8 pa0,bf16x8 pa1,bf16x8 pa2,bf16x8 pa3){
  #pragma unroll
  for(int d0=0;d0<2;++d0){s16x4 lo[4],hi[4];
    #pragma unroll
    for(int ks=0;ks<4;++ks){
      asm volatile("ds_read_b64_tr_b16 %0,%1 offset:%c2":"=&v"(lo[ks]):"v"(vb),"i"(d0*4096+ks*1024):"memory");
      asm volatile("ds_read_b64_tr_b16 %0,%1 offset:%c2":"=&v"(hi[ks]):"v"(vb),"i"(d0*4096+ks*1024+512):"memory");}
    asm volatile("s_waitcnt lgkmcnt(0)":::"memory");SBAR();
    #define PK(k) (bf16x8){lo[k][0],lo[k][1],lo[k][2],lo[k][3],hi[k][0],hi[k][1],hi[k][2],hi[k][3]}
    o[d0]=__builtin_amdgcn_mfma_f32_32x32x16_bf16(pa0,PK(0),o[d0],0,0,0);
    o[d0]=__builtin_amdgcn_mfma_f32_32x32x16_bf16(pa1,PK(1),o[d0],0,0,0);
    o[d0]=__builtin_amdgcn_mfma_f32_32x32x16_bf16(pa2,PK(2),o[d0],0,0,0);
    o[d0]=__builtin_amdgcn_mfma_f32_32x32x16_bf16(pa3,PK(3),o[d0],0,0,0);
    #undef PK
  }
}

#ifndef ATTN_STORE16
#define ATTN_STORE16(p,v) (*(u32x4*)(p)=(v))
#endif
template<int THRL,bool NOFIX=false> __device__ __forceinline__ void attn_unit(int b,int h,int own,const bf16*Q,const bf16*__restrict__ K,const bf16*__restrict__ V,bf16*O,const float*KMP,const float*biasT,char*shm,const int wid){
  int lane=__builtin_amdgcn_mbcnt_hi(~0u,__builtin_amdgcn_mbcnt_lo(~0u,0u)); asm volatile("":"+v"(lane));
  const int tid=wid*64+lane,r32=lane&31,hi=lane>>5;
  const long rowbase=(long)b*SEQ; const int q0=own*QB;
  const bf16*Qw=Q+(rowbase+q0+wid*QBLK)*DM+h*D;
  const bf16*Kh=K+rowbase*DM+h*D,*Vh=V+rowbase*DM+h*D;
  const unsigned lds0=(unsigned)(uintptr_t)shm;
  float*wsf=(float*)(shm+LDS_WS)+wid*64;
  const lds_cptr shm3=(lds_cptr)shm;
  const lds_fptr bt=(lds_fptr)(shm3+LDS_BT);
  const lds_fptr km=(lds_fptr)(shm3+LDS_KM);
  { typedef __attribute__((address_space(3))) float* lds_wptr; const lds_wptr btw=(lds_wptr)(shm3+LDS_BT), kmw=(lds_wptr)(shm3+LDS_KM);
    for(int e=tid;e<640;e+=512){ const int d=e-128; btw[e]=d<0?-INFINITY:(d<128?biasT[h*128+d]:0.f); }
    const int j=tid>>6,d=tid&63;
    if(j<own){ const float*kp=KMP+((size_t)(b*8+j)*4)*1024+h*64+d; kmw[j*64+d]=(kp[0]+kp[1024])+(kp[2048]+kp[3072]); } }
  #define KT(i) (((i)<4)?(4*own+(i)):((i)-4))
  const unsigned koff=(unsigned)(lane*DM+wid*8)*2u;
  const unsigned voff=(unsigned)((16*(wid&3)+(lane>>2))*DM+(wid>>2)*32+(lane&3)*8)*2u;
  const unsigned kdst=lds0+LDS_K+wid*1024, vdst=lds0+LDS_V+wid*1024;
  #define DMA_K(t,slot) glds16(Kh+(long)KT(t)*KVBLK*DM,koff,(unsigned)__builtin_amdgcn_readfirstlane(kdst+(slot)))
  #define DMA_V(t,slot) glds16(Vh+(long)KT(t)*KVBLK*DM,voff,(unsigned)__builtin_amdgcn_readfirstlane(vdst+(slot)))
  const char*Kbase=shm+LDS_K; bf16x8 kf[8];
  const lds_cptr kp0=shm3+LDS_K+hi*1024+r32*16; const lds_cptr vp0=shm3+LDS_V+((lane>>4)&1)*32+(lane&3)*8+(4*hi+((lane&15)>>2))*64;
  const int NT=4*own+4;
  DMA_K(0,0);DMA_V(0,0);DMA_K(1,SLOTB);
  bf16x8 qr[4];
  #pragma unroll
  for(int d0=0;d0<4;++d0)qr[d0]=__builtin_nontemporal_load(reinterpret_cast<const bf16x8*>(&Qw[(long)r32*DM+d0*16+hi*8]));
  float mhat=0.f,l_reg=0.f;f32x16 o[2];o[0]=f32x16{};o[1]=f32x16{};const f32x16 zero16=f32x16{};
  #define qrel (wid*QBLK+r32)
  unsigned selmask=(own<=3)?((1u<<own)-1u):0u;
  #define KEEPF(t,KEEP) do{ if(NOFIX)break; const int t_=(t); \
      if(t_<4){ if(64*t_>32*wid+31) KEEP=false; } else { KEEP=(selmask>>((t_-4)>>2))&1u; } }while(0)
  #define NEEDB(t,NB,B0,B1) do{ NB=false; if(NOFIX)break; const int t_=(t); int dl_=0; \
      if(t_<4){ if(64*t_<=32*wid+31&&32*wid-64*t_-63<113){ NB=true; dl_=qrel-64*t_; } } \
      else if(t_<NT){ const int j_=(t_-4)>>2, tt_=(t_-4)&3; if(j_==own-1&&(256+32*wid-64*tt_-63<113)){ NB=true; dl_=256+qrel-64*tt_; } } \
      if(NB) bias_load(B0,B1,dl_,hi,bt); }while(0)
  bool resc=false;
  #define START(P0,P1) do{ const float rm=rowmax(P0,P1); resc=false; \
    { const float dl=rm; mhat=fadd_s(mhat,dl); \
      _Pragma("unroll") for(int r=0;r<16;++r){P0[r]=fsub_s(P0[r],dl);P1[r]=fsub_s(P1[r],dl);} } \
    _Pragma("unroll") for(int r=0;r<16;++r)P0[r]=__builtin_amdgcn_exp2f(P0[r]); }while(0)
  #define RESC() do{ if(resc){ asm volatile("s_waitcnt lgkmcnt(0)":::"memory"); \
      _Pragma("unroll") for(int d_=0;d_<2;++d_) _Pragma("unroll") for(int r=0;r<16;++r)o[d_][r]*=wsf[crow(r,hi)]; } }while(0)
  int sl_prev=0,sl_cur=0,sl_next=SLOTB;
  #define ROT() do{sl_prev=sl_cur;sl_cur=sl_next;sl_next=(sl_next==(NSLOT-1)*SLOTB)?0:sl_next+SLOTB;}while(0)
  DMA_K(2,2*SLOTB);
  WAIT_BAR(3);
  if(own>=4){
    float b0=-INFINITY,b1=-INFINITY,b2=-INFINITY; int i0=0,i1=0,i2=0;
    for(int j=0;j<own;++j){ float g=0.f;
      #pragma unroll
      for(int d0=0;d0<4;++d0){ const f32x4 ka=*(const __attribute__((address_space(3))) f32x4*)(km+j*64+d0*16+hi*8), kb2=*(const __attribute__((address_space(3))) f32x4*)(km+j*64+d0*16+hi*8+4);
        const bf16x8 qv=qr[d0];
        g+=__uint_as_float((unsigned)(unsigned short)qv[0]<<16)*ka.x; g+=__uint_as_float((unsigned)(unsigned short)qv[1]<<16)*ka.y; g+=__uint_as_float((unsigned)(unsigned short)qv[2]<<16)*ka.z; g+=__uint_as_float((unsigned)(unsigned short)qv[3]<<16)*ka.w;
        g+=__uint_as_float((unsigned)(unsigned short)qv[4]<<16)*kb2.x; g+=__uint_as_float((unsigned)(unsigned short)qv[5]<<16)*kb2.y; g+=__uint_as_float((unsigned)(unsigned short)qv[6]<<16)*kb2.z; g+=__uint_as_float((unsigned)(unsigned short)qv[7]<<16)*kb2.w; }
      { auto rr=__builtin_amdgcn_permlane32_swap(__float_as_uint(g),__float_as_uint(g),false,false); g=__uint_as_float(rr[0])+__uint_as_float(rr[1]); }
      if(g>b0){b2=b1;i2=i1;b1=b0;i1=i0;b0=g;i0=j;} else if(g>b1){b2=b1;i2=i1;b1=g;i1=j;} else if(g>b2){b2=g;i2=j;} }
    selmask=(1u<<i0)|(1u<<i1)|(1u<<i2);
  }
  #define PKW(P,B) cvtpk_s(P[B],P[B+1])
  #define PK4(P,B) (u32x4){PKW(P,B),PKW(P,B+2),PKW(P,B+4),PKW(P,B+6)}
  u32x4 pwA0,pwA1,pwA2,pwA3,pwB0,pwB1,pwB2,pwB3;
  { f32x16 c0,c1;
    bool nb0_; NEEDB(0,nb0_,c0,c1); if(!nb0_){c0=zero16;c1=zero16;}
    qkt(c0,c1,Kbase,qr,c0,c1,r32,hi);asm volatile("s_nop 15\n\ts_nop 7":"+v"(c0),"+v"(c1));
    START(c0,c1);
    _Pragma("unroll") for(int r=0;r<16;++r)c1[r]=__builtin_amdgcn_exp2f(c1[r]);
    float sacc=c0[0]+c0[1]; _Pragma("unroll") for(int r=2;r<16;++r)sacc+=c0[r]; _Pragma("unroll") for(int r=0;r<16;++r)sacc+=c1[r]; l_reg+=sacc;
    pwA0=PK4(c0,0);pwA1=PK4(c0,8);pwA2=PK4(c1,0);pwA3=PK4(c1,8); }
  const __attribute__((address_space(3))) bf16x8* qlp=(const __attribute__((address_space(3))) bf16x8*)(shm3+LDS_QP)+tid;
  { __attribute__((address_space(3))) bf16x8* qw=(__attribute__((address_space(3))) bf16x8*)(shm3+LDS_QP)+tid;
    _Pragma("unroll") for(int d0=0;d0<4;++d0) qw[d0*512]=qr[d0]; }
  #define QL(d0) qlp[(d0)*512]
  bf16x8 qa=QL(0),qb=QL(1);
  WAIT_BAR(0);
  DMA_K(3,0);DMA_V(1,SLOTB);
  ROT();
  kload8(kf,kp0+sl_cur);
  WAIT_BAR(2);
  s16x4 vlo[8],vhi[8];
  #define PAFV(v) __builtin_bit_cast(bf16x8,v)
  #define VFR(i) (bf16x8){vlo[i][0],vlo[i][1],vlo[i][2],vlo[i][3],vhi[i][0],vhi[i][1],vhi[i][2],vhi[i][3]}
  #define PIN(x) asm volatile("":"+v"(x))
  #define MX3(a,b,c) __builtin_fmaxf(__builtin_fmaxf((a),(b)),(c))
  #define GAPA(MF) do{ MF; SBAR(); }while(0)
  #define EX(v) __builtin_amdgcn_exp2f(v)
  #define GAPB(MF,X,B,PK) do{ MF; X[B]=EX(X[B]); X[B+1]=EX(X[B+1]); X[B+2]=EX(X[B+2]); X[B+3]=EX(X[B+3]); sacc+=X[B]; sacc+=X[B+1]; sacc+=X[B+2]; sacc+=X[B+3]; PIN(sacc); PIN(X); PK; SBAR(); }while(0)
  #define VRD(i) do{ vlo[i]=vtr(vp_+(((i)>>2)*4096+((i)&3)*1024)); vhi[i]=vtr(vp_+(((i)>>2)*4096+((i)&3)*1024+512)); }while(0)
  #define KRD(j) do{ kload2(kf,kp0+sl_next,j); SBAR(); }while(0)
  #define STEP(I0,I1,I2,I3,O0,O1,O2,O3,t,GK,GV) do{ SBAR(); \
    const lds_cptr vp_=vp0+sl_prev; f32x16 C0,C1; bool nb; NEEDB(t,nb,C0,C1); \
    VRD(0); SBAR(); \
    if(nb){ GAPA(C0=__builtin_amdgcn_mfma_f32_32x32x16_bf16(kf[0],qa,C0,0,0,0)); VRD(4); SBAR(); GAPA(C1=__builtin_amdgcn_mfma_f32_32x32x16_bf16(kf[1],qa,C1,0,0,0)); } \
    else  { GAPA(C0=__builtin_amdgcn_mfma_f32_32x32x16_bf16(kf[0],qa,zero16,0,0,0)); VRD(4); SBAR(); GAPA(C1=__builtin_amdgcn_mfma_f32_32x32x16_bf16(kf[1],qa,zero16,0,0,0)); } \
    qa=QL(2); VRD(1); SBAR(); GAPA(C0=__builtin_amdgcn_mfma_f32_32x32x16_bf16(kf[2],qb,C0,0,0,0)); \
    VRD(5); SBAR(); GAPA(C1=__builtin_amdgcn_mfma_f32_32x32x16_bf16(kf[3],qb,C1,0,0,0)); \
    qb=QL(3); VRD(2); SBAR(); GAPA(C0=__builtin_amdgcn_mfma_f32_32x32x16_bf16(kf[4],qa,C0,0,0,0)); \
    VRD(6); SBAR(); GAPA(C1=__builtin_amdgcn_mfma_f32_32x32x16_bf16(kf[5],qa,C1,0,0,0)); \
    VRD(3); SBAR(); GAPA(C0=__builtin_amdgcn_mfma_f32_32x32x16_bf16(kf[6],qb,C0,0,0,0)); \
    VRD(7); SBAR(); GAPA(C1=__builtin_amdgcn_mfma_f32_32x32x16_bf16(kf[7],qb,C1,0,0,0)); \
    if(GK){DMA_K((t)+3,sl_cur);} if(GV){DMA_V((t)+1,sl_next);} \
    bool keep_=true; KEEPF(t,keep_); \
    { float a=MX3(C0[0],C0[1],C1[0]),b=MX3(C0[2],C0[3],C1[1]); a=MX3(a,C1[2],C1[3]); \
      _Pragma("unroll") for(int r=4;r<16;r+=4){a=MX3(a,C0[r],C0[r+1]);b=MX3(b,C0[r+2],C0[r+3]);a=MX3(a,C1[r],C1[r+1]);b=MX3(b,C1[r+2],C1[r+3]);} \
      float rm=__builtin_fmaxf(a,b); { auto rr=__builtin_amdgcn_permlane32_swap(__float_as_uint(rm),__float_as_uint(rm),false,false); rm=__builtin_fmaxf(__uint_as_float(rr[0]),__uint_as_float(rr[1])); } \
      rm=keep_?rm-mhat:-INFINITY; resc=false; \
      if(__builtin_expect(__any(rm>(float)THRL),0)){ const float dl=__builtin_fmaxf(rm,0.f); mhat+=dl; \
        const float f=__builtin_amdgcn_exp2f(-dl); l_reg*=f; if(hi==0)wsf[r32]=f; resc=true; } \
      const float msub=keep_?mhat:INFINITY; \
      _Pragma("unroll") for(int r=0;r<16;++r){C0[r]-=msub;C1[r]-=msub;} } \
    SBAR(); float sacc=0.f; \
    GAPB(o[0]=__builtin_amdgcn_mfma_f32_32x32x16_bf16(PAFV(I0),VFR(0),o[0],0,0,0), C0,0, ); \
    GAPB(o[1]=__builtin_amdgcn_mfma_f32_32x32x16_bf16(PAFV(I0),VFR(4),o[1],0,0,0), C0,4, ); \
    KRD(0); GAPB(o[0]=__builtin_amdgcn_mfma_f32_32x32x16_bf16(PAFV(I1),VFR(1),o[0],0,0,0), C0,8,  O0[0]=PKW(C0,0);O0[1]=PKW(C0,2);PIN(O0)); \
    KRD(1); GAPB(o[1]=__builtin_amdgcn_mfma_f32_32x32x16_bf16(PAFV(I1),VFR(5),o[1],0,0,0), C0,12, O0[2]=PKW(C0,4);O0[3]=PKW(C0,6);PIN(O0)); \
    KRD(2); GAPB(o[0]=__builtin_amdgcn_mfma_f32_32x32x16_bf16(PAFV(I2),VFR(2),o[0],0,0,0), C1,0,  O1[0]=PKW(C0,8);O1[1]=PKW(C0,10);PIN(O1)); \
    KRD(3); GAPB(o[1]=__builtin_amdgcn_mfma_f32_32x32x16_bf16(PAFV(I2),VFR(6),o[1],0,0,0), C1,4,  O1[2]=PKW(C0,12);O1[3]=PKW(C0,14);PIN(O1)); \
    GAPB(o[0]=__builtin_amdgcn_mfma_f32_32x32x16_bf16(PAFV(I3),VFR(3),o[0],0,0,0), C1,8,  O2[0]=PKW(C1,0);O2[1]=PKW(C1,2);PIN(O2)); \
    GAPB(o[1]=__builtin_amdgcn_mfma_f32_32x32x16_bf16(PAFV(I3),VFR(7),o[1],0,0,0), C1,12, O2[2]=PKW(C1,4);O2[3]=PKW(C1,6);PIN(O2)); \
    O3=PK4(C1,8); l_reg+=sacc; qa=QL(0); qb=QL(1); \
    }while(0)
  #define ENDW(tt) do{ if((tt)+3<NT){WAIT_BAR(2);} else if((tt)+2<NT){WAIT_BAR(1);} else {WAIT_BAR(0);} }while(0)
  int t=1;
  for(;t+1<NT;t+=2){
    STEP(pwA0,pwA1,pwA2,pwA3,pwB0,pwB1,pwB2,pwB3,t,(t+3<NT),(t+1<NT));       ENDW(t);   RESC(); ROT();
    STEP(pwB0,pwB1,pwB2,pwB3,pwA0,pwA1,pwA2,pwA3,t+1,(t+4<NT),(t+2<NT));     ENDW(t+1); RESC(); ROT();
  }
  STEP(pwA0,pwA1,pwA2,pwA3,pwB0,pwB1,pwB2,pwB3,NT-1,false,false); RESC();
  { SBAR(); pv(o,(int)(unsigned)(uintptr_t)(vp0+sl_cur),PAFV(pwB0),PAFV(pwB1),PAFV(pwB2),PAFV(pwB3)); }
  #undef PK4
  #undef QL
  #undef PAFV
  #undef PKW
  #undef VFR
  #undef PIN
  #undef MX3
  #undef GAPA
  #undef GAPB
  #undef EX
  #undef VRD
  #undef KRD
  #undef STEP
  #undef ENDW
  {auto rr=__builtin_amdgcn_permlane32_swap(__float_as_uint(l_reg),__float_as_uint(l_reg),false,false);l_reg=__uint_as_float(rr[0])+__uint_as_float(rr[1]);}
  if(hi==0)wsf[32+r32]=l_reg;asm volatile("s_waitcnt lgkmcnt(0)":::"memory");
  float rli[16];
  #pragma unroll
  for(int r=0;r<16;++r)rli[r]=__builtin_amdgcn_rcpf(wsf[32+crow(r,hi)]);
  bf16*Ow=O+(rowbase+q0+wid*QBLK)*DM+h*D;
  { bf16*stg=(bf16*)(shm+LDS_OST)+wid*2048;
    #pragma unroll
    for(int r=0;r<16;++r){const int orow=crow(r,hi);
      #pragma unroll
      for(int d0=0;d0<2;++d0)stg[orow*64+d0*32+r32]=__float2bfloat16(o[d0][r]*rli[r]);}
    asm volatile("s_waitcnt lgkmcnt(0)":::"memory");
    #pragma unroll
    for(int i=0;i<4;++i){const int row=i*8+(lane>>3),ch=lane&7; const u32x4 v=*(const u32x4*)(stg+row*64+ch*8); ATTN_STORE16(Ow+(long)row*DM+ch*8,v);} }
  asm volatile("s_waitcnt lgkmcnt(0)\n\ts_barrier":::"memory");
  #undef DMA_K
  #undef DMA_V
  #undef KT
  #undef qrel
  #undef KEEPF
  #undef NEEDB
  #undef START
  #undef RESC
  #undef ROT
}
constexpr int ATTN_LDS_BYTES=LDS_BYTES;
#undef SBAR
#undef WAIT_BAR
}
#define GAS __attribute__((address_space(1)))
typedef GAS unsigned gu32;
#define RLX_AGENT __ATOMIC_RELAXED, __HIP_MEMORY_SCOPE_AGENT
#define XB_TMO      128
#define XB_XCNT(j)  (256  + 64 * (j))
#define XB_XSUB(j)  (1280 + 64 * (j))
#define XB_XGEN(j)  (2304 + 64 * (j))
#define XB_TOP      3328
#define XB_TOPGEN   3392
#define XCD_BAR_WORDS 3456
#define XB_SPIN_CAP (1u << 18)

__device__ __forceinline__ unsigned xb_ld(unsigned* p)              { return __hip_atomic_load(p, __ATOMIC_RELAXED, __HIP_MEMORY_SCOPE_AGENT); }
__device__ __forceinline__ unsigned xb_add(unsigned* p, unsigned v) { return __hip_atomic_fetch_add(p, v, __ATOMIC_RELAXED, __HIP_MEMORY_SCOPE_AGENT); }
__device__ __forceinline__ unsigned xb_xcc_id() { return (unsigned)__builtin_amdgcn_s_getreg((3 << 11) | 20) & 0xFu; }
#define XB_SPIN(cond, bar) do { unsigned _sp = 0; while (cond) { __builtin_amdgcn_s_sleep(1); \
    if ((++_sp & 255u) == 0u) { if (xb_ld(&(bar)[XB_TMO])) break; if (_sp > XB_SPIN_CAP) { atomicAdd(&(bar)[XB_TMO], 1u); break; } } } } while (0)

struct XcdBarrier {
    unsigned* bar; unsigned x;
    volatile LAS unsigned* st;
};

__device__ __forceinline__ XcdBarrier xcd_barrier_post(unsigned* bar, volatile LAS unsigned* st, const bool t0) {
    XcdBarrier b; b.bar = bar; b.x = xb_xcc_id(); b.st = st;
    if (t0) (void)xb_add(&bar[XB_XCNT(b.x)], 1u);
    return b;
}
__device__ __forceinline__ void xcd_barrier_complete(unsigned* bar, unsigned x, unsigned& nloc, unsigned& nx) {
    const unsigned G = gridDim.x * gridDim.y * gridDim.z;
    unsigned sum, cnt, mine, sp = 0u;
    for (;;) {
        sum = 0u; cnt = 0u; mine = 0u;
#pragma unroll
        for (unsigned j = 0; j < 16; ++j) { const unsigned c = xb_ld(&bar[XB_XCNT(j)]); sum += c; cnt += (c > 0u) ? 1u : 0u; mine = (j == x) ? c : mine; }
        if (sum == G) break;
        __builtin_amdgcn_s_sleep(1);
        if ((++sp & 255u) == 0u) { if (xb_ld(&bar[XB_TMO])) break; if (sp > XB_SPIN_CAP) { atomicAdd(&bar[XB_TMO], 1u); break; } }
    }
    nloc = mine > 0u ? mine : 1u; nx = cnt > 0u ? cnt : 1u;
}

__device__ __forceinline__ void xcd_barrier(const XcdBarrier& b, const bool t0) {
    asm volatile("s_waitcnt vmcnt(0)" ::: "memory");
    __syncthreads();
    if (t0) {
        unsigned* bar = b.bar;
        __builtin_amdgcn_s_waitcnt(0);
        unsigned nloc = b.st[0], nx = b.st[1];
        if (nloc == 0u) { xcd_barrier_complete(bar, b.x, nloc, nx); b.st[0] = nloc; b.st[1] = nx; }
        const unsigned old = xb_add(&bar[XB_XSUB(b.x)], 1u);
        const unsigned gen = old / nloc;
        if (old + 1u == (gen + 1u) * nloc) {
            __builtin_amdgcn_fence(__ATOMIC_RELEASE, "agent");
            asm volatile("s_waitcnt vmcnt(0)" ::: "memory");
            const unsigned og = xb_add(&bar[XB_TOP], 1u);
            const unsigned tg = og / nx;
            if (og + 1u == (tg + 1u) * nx) xb_add(&bar[XB_TOPGEN], 1u);
            else XB_SPIN(xb_ld(&bar[XB_TOPGEN]) == tg, bar);
            __builtin_amdgcn_fence(__ATOMIC_ACQUIRE, "agent");
            xb_add(&bar[XB_XGEN(b.x)], 1u);
            asm volatile("s_waitcnt vmcnt(0)" ::: "memory");
        } else {
            XB_SPIN(xb_ld(&bar[XB_XGEN(b.x)]) == gen, bar);
            __builtin_amdgcn_fence(__ATOMIC_ACQUIRE, "agent");
            asm volatile("s_waitcnt vmcnt(0)" ::: "memory");
        }
    }
    __syncthreads();
}
constexpr int NWAVES = 8;
constexpr int RING_OFF = 0, RING_BYTES = 131072;
constexpr int LDSCTL_OFF = RING_BYTES;
constexpr int LDS_BYTES = 147456;
constexpr int CW_BAR = 4096;
#ifndef PROBE_EXTRA
#define PROBE_EXTRA 0
#endif
#ifndef PROBE_KIND
#define PROBE_KIND K_ATTN
#endif
constexpr int N_PHASES = 17 + PROBE_EXTRA;
constexpr int CW_FIN = 16384;
enum { K_PROLOGUE = 0, K_POOL, K_POOLGEMM_UNUSED, K_UP, K_DOWN, K_QGEMM, K_ATTN, K_WO, K_FINAL };
#ifndef REP_KIND
#define REP_KIND -1
#endif
#ifndef REP_N
#define REP_N 2
#endif
constexpr size_t WS_DUMMY = 268 * MiB;
#ifndef NAIVE_ATTN
#define NAIVE_ATTN 0
#endif

struct Args { Params p; int ph_lo, ph_hi; };

__global__ void __launch_bounds__(NWAVES * 64, 2) mk_fwd(Args args) {
    extern __shared__ __attribute__((aligned(16))) unsigned char lds_raw[];
    asm volatile("s_nop 0\n\ts_nop 0\n\ts_nop 0\n\ts_nop 0\n\ts_nop 0\n\ts_nop 0\n\ts_nop 0" ::: "memory");
    LAS unsigned char* lds = (LAS unsigned char*)lds_raw;
    typedef const __attribute__((address_space(4))) Args* KArgs;
    const int tid0 = threadIdx.x, wave = __builtin_amdgcn_readfirstlane(tid0 >> 6);
    const int G = gridDim.x;
    unsigned char* ws0 = args.p.ws;
    volatile LAS unsigned* LCTL = (volatile LAS unsigned*)(lds + LDSCTL_OFF);
    for (int u = tid0; u < (LDS_BYTES - LDSCTL_OFF) / 4; u += NWAVES * 64) ((LAS unsigned*)(lds + LDSCTL_OFF))[u] = 0u;
    __syncthreads();
    const int lo = args.ph_lo, hi = args.ph_hi;
    const bool multi = (hi - lo) > 1;
    XcdBarrier bar; bar.bar = (unsigned*)(ws0 + WS_CTL) + CW_BAR; bar.x = 0; bar.st = nullptr;
    if (multi) bar = xcd_barrier_post((unsigned*)(ws0 + WS_CTL) + CW_BAR, LCTL + 8, tid0 == 0);
    const int gw = blockIdx.x * NWAVES + wave, NGW = G * NWAVES;

    static_assert(WS_V - WS_K == (size_t)M * D * 2, "V follows K");
    for (int ph = lo; ph < hi; ++ph) {
#define IS_T0 (wave == 0 && __builtin_amdgcn_mbcnt_hi(~0u, __builtin_amdgcn_mbcnt_lo(~0u, 0u)) == 0u)
#define PHASE_TID int lane = __builtin_amdgcn_mbcnt_hi(~0u, __builtin_amdgcn_mbcnt_lo(~0u, 0u)); asm volatile("" : "+v"(lane)); const int tid = wave * 64 + lane; (void)tid
        KArgs ka = (KArgs)__builtin_amdgcn_kernarg_segment_ptr(); asm volatile("" : "+s"(ka));
        size_t wsz = 0; asm volatile("" : "+s"(wsz)); unsigned char* ws = ka->p.ws + wsz;
        const int cb = (ph == 2 || ph == 3) ? 1 : 0;
        bf16_t* XB = (bf16_t*)(ws + (cb ? WS_K : WS_XB)); float* SS = (float*)(ws + (cb ? WS_SS2 : WS_SS)); bf16_t* ACT = (bf16_t*)(ws + WS_ACT);
        bf16_t* Kb = (bf16_t*)(ws + WS_K); bf16_t* Vb = (bf16_t*)(ws + WS_V); bf16_t* Qb = (bf16_t*)(ws + WS_Q); bf16_t* Ob = (bf16_t*)(ws + WS_O); bf16_t* Dp = (bf16_t*)(ws + WS_DP);
        float* KMP = (float*)(ws + WS_KMP); float* biasT = (float*)(ws + WS_BIAS);
        int kind, layer;
        if (ph == 0) { kind = K_PROLOGUE; layer = 0; }
        else if (PROBE_EXTRA > 0 && ph >= 17) { kind = PROBE_KIND; layer = 3; }
        else if (ph <= 6) { layer = (ph - 1) / 3; const int s = (ph - 1) % 3; kind = s == 0 ? K_POOL : (s == 1 ? K_UP : K_DOWN); }
        else { const int q = ph - 7; layer = 2 + q / 5; const int s = q % 5; kind = s == 0 ? K_QGEMM : (s == 1 ? K_ATTN : (s == 2 ? K_WO : (s == 3 ? K_UP : K_DOWN))); }

        const int reps = (REP_KIND >= 0 && kind == REP_KIND) ? REP_N : 1;
        for (int rep = 0; rep < reps; ++rep) {
        if (kind == K_PROLOGUE) { PHASE_TID;
            LAS float* scr = (LAS float*)(lds + RING_OFF + wave * 16384);
            Params p; p.x = ka->p.x; p.norm_mixer = ka->p.norm_mixer; p.norm_ffn = ka->p.norm_ffn; p.pool_w = ka->p.pool_w; p.pool_scale = ka->p.pool_scale; p.kv_norm = ka->p.kv_norm; p.w_kv = ka->p.w_kv; p.w_q = ka->p.w_q;
            p.w_o = ka->p.w_o; p.rel_bias = ka->p.rel_bias; p.w_gate_up = ka->p.w_gate_up; p.w_down = ka->p.w_down; p.final_norm = ka->p.final_norm; p.out = ka->p.out; p.ws = ws;
            for (int it = gw; it < IT_TOTAL; it += NGW) conv_dispatch(p, it, scr, lane);
            for (int r = gw; r < M; r += NGW) rowprep(p.x, XB, SS, r, lane);
            const int t = blockIdx.x * (NWAVES * 64) + tid;
            if (t < NH * 128) { const int h = t >> 7, d = t & 127; biasT[t] = (p.rel_bias[rel_bucket(d) * NH + h] - p.rel_bias[31 * NH + h]) * LOG2E; }
        } else if (kind == K_POOL) { PHASE_TID;
            const int ib = layer;
            const bf16_t* XBi = (const bf16_t*)(ws + (ib ? WS_K : WS_XB)); const float* SSi = (const float*)(ws + (ib ? WS_SS2 : WS_SS));
            pg8::EpiResid E; E.XB = XBi; E.XBo = (bf16_t*)(ws + (ib ? WS_XB : WS_K)); E.SS = (float*)(ws + (ib ? WS_SS : WS_SS2)); E.fout = nullptr; E.gfin = nullptr; E.slots = nullptr; E.cnt = nullptr; E.tid = tid;
            if (rep > 0) { E.XBo = (bf16_t*)(ws + WS_DUMMY); E.SS = (float*)(ws + WS_DUMMY); }
            pg8::StaticOrder S; S.init(M, D, G, (int)blockIdx.x);
            poolf::pool_phase(lds + RING_OFF, XBi, SSi, (const bf16_t*)(ws + WS_WPOOL) + (size_t)layer * 262144, S, E, tid);
        } else if (kind == K_WO || kind == K_DOWN) { PHASE_TID;
            pg8::Gemm g; pg8::EpiResid E; E.XB = XB; E.XBo = XB; E.SS = SS; g.N = D; g.a_pn_cols = 0; E.fout = nullptr; E.gfin = nullptr; E.slots = nullptr; E.cnt = nullptr; E.tid = tid;
            if (kind == K_DOWN && layer == 3 && rep == 0 && !(PROBE_EXTRA > 0 && ph >= 17)) { E.fout = ka->p.out; E.gfin = ka->p.final_norm; E.slots = (float*)(ws + WS_SS2); E.cnt = (unsigned*)(ws + WS_CTL) + CW_FIN; }
            if (kind == K_WO) { g.A = Ob; g.lda = D; g.Bt = (const bf16_t*)(ws + WS_WO) + (size_t)(layer - 2) * D * D; g.K = D; }
            else { g.A = ACT; g.lda = DFF; g.Bt = (const bf16_t*)(ws + WS_WDN) + (size_t)layer * WDN_STRIDE; g.K = DFF; }
            if (rep > 0 || (PROBE_EXTRA > 0 && ph >= 17)) { E.XBo = (bf16_t*)(ws + WS_DUMMY); E.SS = (float*)(ws + WS_DUMMY); }
            pg8::StaticOrder S; S.init(M, g.N, G, (int)blockIdx.x);
            pg8::gemm_phase<pg8::EpiResid, pg8::StaticOrder>(lds + RING_OFF, g, S, E, tid);
        } else if (kind == K_UP) { PHASE_TID;
            pg8::Gemm g; g.A = XB; g.lda = D; g.Bt = (const bf16_t*)(ws + WS_WGU) + (size_t)layer * WGU_STRIDE; g.K = D; g.N = NGU; g.a_pn_cols = 0;
            pg8::EpiSwiglu E; E.ACT = ACT; E.SS = SS; E.tid = tid; E.skip = 0;
#if defined(REP_VARIANT)
            if (rep > 0) { E.skip = 1; E.ACT = (bf16_t*)(ws + WS_DUMMY); }
#endif
            pg8::rstd_table_reset(tid);
            pg8::TailHalfOrder S; S.init(M, g.N, G, (int)blockIdx.x);
            pg8::gemm_phase<pg8::EpiSwiglu, pg8::TailHalfOrder>(lds + RING_OFF, g, S, E, tid);
        } else if (kind == K_QGEMM) { PHASE_TID;
            pg8::Gemm g; g.A = XB; g.lda = D; g.K = D; g.a_pn_cols = 0;
            pg8::EpiKVQ E; E.Kb = Kb; E.Qb = Qb; E.KMP = KMP; E.SS = SS; E.tid = tid;
            if (layer == 2) { g.Bt = (const bf16_t*)(ws + WS_WKVQ); g.N = 3 * D; E.pn_off = 0; } else { g.Bt = (const bf16_t*)(ws + WS_WQ1); g.N = D; E.pn_off = 8; }
            pg8::rstd_table_reset(tid);
            pg8::StaticOrder S; S.init(M, g.N, G, (int)blockIdx.x);
            pg8::gemm_phase<pg8::EpiKVQ, pg8::StaticOrder>(lds + RING_OFF, g, S, E, tid);
        } else if (kind == K_ATTN) { PHASE_TID;
#if NAIVE_ATTN
            const int hw = blockIdx.x * 2 + (tid >> 8), NHW = G * 2;
            for (int w = hw; w < BATCH * NH * 4; w += NHW) { const int bh = w >> 2, s = w & 3;
                attn_naive_unit(Qb, Kb, Vb, KMP, biasT, Ob, bh >> 4, bh & 15, s, tid & 255);
                attn_naive_unit(Qb, Kb, Vb, KMP, biasT, Ob, bh >> 4, bh & 15, 7 - s, tid & 255); }
#else
            const int bx = blockIdx.x, vcu = (G % 8 == 0) ? (bx % 8) * (G / 8) + bx / 8 : bx;
            for (int u2 = 2 * vcu; u2 < BATCH * NH * 8; u2 += (u2 & 1) ? 2 * G - 1 : 1) { const int pp = u2 >> 1, bh = pp >> 2, s = pp & 3, own = (u2 & 1) ? 7 - s : s;
#if defined(REP_VARIANT)
                if (rep > 0) attn_body::attn_unit<8, true>(bh >> 4, bh & 15, own, (const attn_body::bf16*)Qb, (const attn_body::bf16*)Kb, (const attn_body::bf16*)Vb, (attn_body::bf16*)(ws + WS_DUMMY), KMP, biasT, (char*)lds_raw + RING_OFF, wave); else
#endif
                attn_body::attn_unit<8>(bh >> 4, bh & 15, own, (const attn_body::bf16*)Qb, (const attn_body::bf16*)Kb, (const attn_body::bf16*)Vb, (attn_body::bf16*)Ob, KMP, biasT, (char*)lds_raw + RING_OFF, wave); }
#endif
        }
        if (rep + 1 < reps) xcd_barrier(bar, IS_T0);
        }
        if (multi && ph + 1 < hi) { xcd_barrier(bar, IS_T0); if (REP_KIND == 100) xcd_barrier(bar, IS_T0); }
    }
}

extern "C" void kernel_launch(void* const* d_in, const int* in_sizes, int n_in, void* d_out, int out_size, void* d_ws, size_t ws_size, hipStream_t stream) {
    static int grid = 0;
    if (grid == 0) {
        if (n_in != 13 || in_sizes[0] != M * D || out_size != M * D || ws_size < ((REP_KIND >= 0 || PROBE_EXTRA > 0) ? WS_DUMMY + 64 * MiB : WS_END)) {
            fprintf(stderr, "kernel_launch: unexpected shapes (n_in %d, in0 %d, out %d, ws %zu); nothing launched\n", n_in, n_in > 0 ? in_sizes[0] : -1, out_size, ws_size); grid = -1; return; }
        int dev = 0, cus = 0, per_cu = 0;
        if (hipGetDevice(&dev) != hipSuccess || hipDeviceGetAttribute(&cus, hipDeviceAttributeMultiprocessorCount, dev) != hipSuccess) { fprintf(stderr, "kernel_launch: device query failed\n"); grid = -1; return; }
        if (hipFuncSetAttribute((const void*)mk_fwd, hipFuncAttributeMaxDynamicSharedMemorySize, LDS_BYTES) != hipSuccess) { fprintf(stderr, "kernel_launch: hipFuncSetAttribute failed\n"); grid = -1; return; }
        if (hipOccupancyMaxActiveBlocksPerMultiprocessor(&per_cu, (const void*)mk_fwd, NWAVES * 64, LDS_BYTES) != hipSuccess || per_cu < 1) {
            fprintf(stderr, "kernel_launch: occupancy query reports %d workgroups per CU; nothing launched\n", per_cu); (void)hipGetLastError(); grid = -1; return; }
        grid = cus;
        if (grid > 256) grid = 256;
    }
    if (grid < 0) return;
    if (hipMemsetAsync((char*)d_ws + WS_CTL, 0, 1 * MiB, stream) != hipSuccess) { fprintf(stderr, "kernel_launch: hipMemsetAsync failed\n"); return; }
    Args a{};
    a.p.x = (const float*)d_in[0]; a.p.norm_mixer = (const float*)d_in[1]; a.p.norm_ffn = (const float*)d_in[2]; a.p.pool_w = (const float*)d_in[3]; a.p.pool_scale = (const float*)d_in[4];
    a.p.kv_norm = (const float*)d_in[5]; a.p.w_kv = (const float*)d_in[6]; a.p.w_q = (const float*)d_in[7]; a.p.w_o = (const float*)d_in[8]; a.p.rel_bias = (const float*)d_in[9];
    a.p.w_gate_up = (const float*)d_in[10]; a.p.w_down = (const float*)d_in[11]; a.p.final_norm = (const float*)d_in[12];
    a.p.out = (float*)d_out; a.p.ws = (unsigned char*)d_ws;
    a.ph_lo = 0; a.ph_hi = N_PHASES;
    hipLaunchKernelGGL(mk_fwd, dim3(grid), dim3(NWAVES * 64), LDS_BYTES, stream, a);
    const hipError_t le = hipPeekAtLastError();
    if (le != hipSuccess) fprintf(stderr, "kernel_launch: launch failed: %s\n", hipGetErrorName(le));
}
```

```cpp
#include <hip/hip_runtime.h>
#include <cstdio>
#include <cstdint>

#define LAS __attribute__((address_space(3)))
typedef unsigned short bf16_t;
typedef short bf16x8 __attribute__((ext_vector_type(8)));
typedef float f32x4 __attribute__((ext_vector_type(4)));
typedef unsigned u32x4 __attribute__((ext_vector_type(4)));
typedef unsigned u32x2 __attribute__((ext_vector_type(2)));
typedef float f32x2_t __attribute__((ext_vector_type(2)));
typedef __bf16 bf16x2_t __attribute__((ext_vector_type(2)));

constexpr int BATCH = 8, SEQ = 2048, D = 1024, M = BATCH * SEQ, DFF = 2816, NGU = 2 * DFF, NH = 16, HD = 64, NBLK = SEQ / 256;
constexpr float EPS = 1e-6f;
constexpr float QSCALE = 0.125f * 1.4426950408889634f;
constexpr float LOG2E = 1.4426950408889634f;

constexpr size_t MiB = 1u << 20;
constexpr size_t WS_CTL = 0;
constexpr size_t WS_KMP = 1 * MiB;
constexpr size_t WS_SS = 2 * MiB;
constexpr size_t WS_BIAS = 3 * MiB;
constexpr size_t WS_WPOOL = 4 * MiB;
constexpr size_t WS_WKVQ = 5 * MiB;
constexpr size_t WS_WQ1 = 11 * MiB;
constexpr size_t WS_WO = 13 * MiB;
constexpr size_t WS_WGU = 17 * MiB;
constexpr size_t WS_WDN = 61 * MiB;
constexpr size_t WS_SS2 = 83 * MiB;
constexpr size_t WS_XB = 84 * MiB;
constexpr size_t WS_K = 116 * MiB;
constexpr size_t WS_V = 148 * MiB;
constexpr size_t WS_ACT = 180 * MiB;
constexpr size_t WS_Q = WS_ACT, WS_O = WS_ACT + 32 * MiB, WS_DP = WS_ACT;
constexpr size_t WS_END = 268 * MiB;
constexpr size_t WGU_STRIDE = (size_t)NGU * D, WDN_STRIDE = (size_t)D * DFF;

__device__ __forceinline__ unsigned cvtpk(float lo, float hi) { f32x2_t v = {lo, hi}; bf16x2_t b = __builtin_convertvector(v, bf16x2_t); return __builtin_bit_cast(unsigned, b); }
__device__ __forceinline__ void st16_wt(void* p, u32x4 v) { asm volatile("global_store_dwordx4 %0, %1, off sc1\n\ts_nop 1" :: "v"(p), "v"(v) : "memory"); }
__device__ __forceinline__ float bf_lo(unsigned w) { return __uint_as_float(w << 16); }
__device__ __forceinline__ float bf_hi(unsigned w) { return __uint_as_float(w & 0xffff0000u); }
template <int CTRL> __device__ __forceinline__ float dpp_f(float v) { return __uint_as_float((unsigned)__builtin_amdgcn_update_dpp(0, (int)__float_as_uint(v), CTRL, 0xf, 0xf, false)); }
__device__ __forceinline__ float row16_sum(float v) { v += dpp_f<0x128>(v); v += dpp_f<0x124>(v); v += dpp_f<0x122>(v); v += dpp_f<0x121>(v); return v; }
__device__ __forceinline__ float xor16_sum(float v) { auto r = __builtin_amdgcn_permlane16_swap(__float_as_uint(v), __float_as_uint(v), false, false); return __uint_as_float(r[0]) + __uint_as_float(r[1]); }
__device__ __forceinline__ float xor32_sum(float v) { auto r = __builtin_amdgcn_permlane32_swap(__float_as_uint(v), __float_as_uint(v), false, false); return __uint_as_float(r[0]) + __uint_as_float(r[1]); }
__device__ __forceinline__ float wave_sum(float v) { return xor32_sum(xor16_sum(row16_sum(v))); }
__device__ __forceinline__ float lane_bcast(float v, int l) { return __uint_as_float((unsigned)__builtin_amdgcn_readlane((int)__float_as_uint(v), l)); }
__device__ __forceinline__ float row_rstd(const float* SS, int row) {
    const f32x4* p = (const f32x4*)(SS + (size_t)row * 16);
    const f32x4 a = p[0], b = p[1], c = p[2], d = p[3];
    const float s = (((a.x + a.y) + (a.z + a.w)) + ((b.x + b.y) + (b.z + b.w))) + (((c.x + c.y) + (c.z + c.w)) + ((d.x + d.y) + (d.z + d.w)));
    return 1.0f / sqrtf(s * (1.0f / D) + EPS);
}
__device__ __forceinline__ int rel_bucket(int n) {
    if (n < 16) return n;
    int b = 16;
    b += (n >= 19); b += (n >= 21); b += (n >= 24); b += (n >= 27); b += (n >= 31); b += (n >= 35); b += (n >= 40); b += (n >= 46);
    b += (n >= 52); b += (n >= 59); b += (n >= 67); b += (n >= 77); b += (n >= 87); b += (n >= 99); b += (n >= 113);
    return b;
}

struct Params {
    const float* x; const float* norm_mixer; const float* norm_ffn; const float* pool_w; const float* pool_scale; const float* kv_norm;
    const float* w_kv; const float* w_q; const float* w_o; const float* rel_bias; const float* w_gate_up; const float* w_down; const float* final_norm;
    float* out; unsigned char* ws;
};

__device__ __forceinline__ void conv_item(const float* W, int ldw, int k0, int ns0, bf16_t* WT, int ldt, int nd0, const float* gk, const float* gn, float cs, LAS float* scr, int lane) {
    const int c4 = (lane & 7) * 4, kr = lane >> 3;
    f32x4 sn = (f32x4){cs, cs, cs, cs}; if (gn) sn = sn * *(const f32x4*)(gn + ns0 + c4);
    f32x4 w[8];
#pragma unroll
    for (int i = 0; i < 8; ++i) w[i] = __builtin_nontemporal_load((const f32x4*)(W + (size_t)(k0 + 8 * i + kr) * ldw + ns0 + c4));
#pragma unroll
    for (int i = 0; i < 8; ++i) { const int kk = 8 * i + kr; f32x4 v = w[i] * sn; if (gk) v = v * gk[k0 + kk];
        LAS float* d = scr + kk * 33 + c4; d[0] = v.x; d[1] = v.y; d[2] = v.z; d[3] = v.w; }
    asm volatile("s_waitcnt lgkmcnt(0)" ::: "memory");
    const int ch = lane & 7;
#pragma unroll
    for (int j = 0; j < 4; ++j) { const int n = (lane >> 3) + 8 * j; const LAS float* s = scr + (8 * ch) * 33 + n;
        u32x4 o; o.x = cvtpk(s[0 * 33], s[1 * 33]); o.y = cvtpk(s[2 * 33], s[3 * 33]); o.z = cvtpk(s[4 * 33], s[5 * 33]); o.w = cvtpk(s[6 * 33], s[7 * 33]);
        *(u32x4*)(WT + (size_t)(nd0 + n) * ldt + k0 + 8 * ch) = o; }
    asm volatile("s_waitcnt lgkmcnt(0)" ::: "memory");
}
constexpr int IT_POOL = 8 * 32, IT_KV = 16 * 64, IT_Q = 16 * 32, IT_O = 16 * 32, IT_GU = 16 * 176, IT_DN = 44 * 32;
constexpr int IT_TOTAL = IT_POOL + IT_KV + 2 * IT_Q + 2 * IT_O + 4 * IT_GU + 4 * IT_DN;
__device__ __forceinline__ void conv_dispatch(const Params& p, int it, LAS float* scr, int lane) {
    unsigned char* ws = p.ws;
    int r = it;
    if (r < IT_POOL) { const int lg = r >> 5, l = lg >> 2, g = lg & 3, q = r & 31, kb = q >> 3, nb = q & 7;
        conv_item(p.pool_w + (size_t)lg * 65536, 256, 64 * kb, 32 * nb, (bf16_t*)(ws + WS_WPOOL) + (size_t)l * 262144, 256, 256 * g + 32 * nb,
                  p.norm_mixer + l * D + 256 * g, p.pool_scale + l * D + 256 * g, 1.f, scr, lane); return; } r -= IT_POOL;
    if (r < IT_KV) { const int kb = r >> 6, nb = r & 63;
        conv_item(p.w_kv, 2048, 64 * kb, 32 * nb, (bf16_t*)(ws + WS_WKVQ), D, 32 * nb, p.kv_norm, nullptr, 1.f, scr, lane); return; } r -= IT_KV;
    if (r < 2 * IT_Q) { const int j = r / IT_Q, q = r % IT_Q, kb = q >> 5, nb = q & 31;
        bf16_t* dst = j == 0 ? (bf16_t*)(ws + WS_WKVQ) + (size_t)2048 * D : (bf16_t*)(ws + WS_WQ1);
        conv_item(p.w_q + (size_t)j * D * D, D, 64 * kb, 32 * nb, dst, D, 32 * nb, p.norm_mixer + (2 + j) * D, nullptr, QSCALE, scr, lane); return; } r -= 2 * IT_Q;
    if (r < 2 * IT_O) { const int j = r / IT_O, q = r % IT_O, kb = q >> 5, nb = q & 31;
        conv_item(p.w_o + (size_t)j * D * D, D, 64 * kb, 32 * nb, (bf16_t*)(ws + WS_WO) + (size_t)j * D * D, D, 32 * nb, nullptr, nullptr, 1.f, scr, lane); return; } r -= 2 * IT_O;
    if (r < 4 * IT_GU) { const int l = r / IT_GU, q = r % IT_GU, kb = q / 176, nb = q % 176;
        const int nd0 = 32 * nb, pn = nd0 >> 8, bj = (nd0 >> 7) & 1, i = nd0 & 127, ns0 = bj * DFF + 128 * pn + i;
        conv_item(p.w_gate_up + (size_t)l * D * NGU, NGU, 64 * kb, ns0, (bf16_t*)(ws + WS_WGU) + (size_t)l * WGU_STRIDE, D, nd0, p.norm_ffn + l * D, nullptr, 1.f, scr, lane); return; } r -= 4 * IT_GU;
    { const int l = r / IT_DN, q = r % IT_DN, kb = q >> 5, nb = q & 31;
        conv_item(p.w_down + (size_t)l * DFF * D, D, 64 * kb, 32 * nb, (bf16_t*)(ws + WS_WDN) + (size_t)l * WDN_STRIDE, DFF, 32 * nb, nullptr, nullptr, 1.f, scr, lane); }
}

__device__ __forceinline__ void rowprep(const float* x, bf16_t* XB, float* SS, int row, int lane) {
    const f32x4* xr = (const f32x4*)(x + (size_t)row * D) + lane;
    f32x4 v[4]; float s = 0.f; u32x2 w[4];
#pragma unroll
    for (int j = 0; j < 4; ++j) v[j] = __builtin_nontemporal_load(xr + 64 * j);
#pragma unroll
    for (int j = 0; j < 4; ++j) { w[j].x = cvtpk(v[j].x, v[j].y); w[j].y = cvtpk(v[j].z, v[j].w);
        const float a = bf_lo(w[j].x), b = bf_hi(w[j].x), c = bf_lo(w[j].y), d = bf_hi(w[j].y); s += (a * a + b * b) + (c * c + d * d); }
    s = wave_sum(s);
    u32x2* o = (u32x2*)(XB + (size_t)row * D) + lane;
#pragma unroll
    for (int j = 0; j < 4; ++j) o[64 * j] = w[j];
    if (lane < 16) SS[(size_t)row * 16 + lane] = lane == 0 ? s : 0.f;
}

__device__ __forceinline__ void final_row(const bf16_t* XB, float* out, const float* SS, const float* g, int row, int lane) {
    const float r = row_rstd(SS, row);
    const u32x2* xr = (const u32x2*)(XB + (size_t)row * D) + lane; f32x4* orow = (f32x4*)(out + (size_t)row * D) + lane; const f32x4* gr = (const f32x4*)g + lane;
#pragma unroll
    for (int j = 0; j < 4; ++j) { const u32x2 w = xr[64 * j]; const f32x4 gg = gr[64 * j]; const f32x4 v = (f32x4){bf_lo(w.x), bf_hi(w.x), bf_lo(w.y), bf_hi(w.y)}; orow[64 * j] = v * r * gg; }
}

struct Epi {
    const float* base; float* XF; bf16_t* XB; float* SS; bf16_t* ACT; bf16_t* Kb; bf16_t* Vb; bf16_t* Qb; float* KMP;
};
__device__ __forceinline__ float silu_mul(float g, float u) { return g * __builtin_amdgcn_rcpf(1.0f + __builtin_amdgcn_exp2f(g * -LOG2E)) * u; }

namespace pg8 {
#define PG8_LAS __attribute__((address_space(3)))
constexpr int BM = 256, BK = 64, HALF = 128, HTB = HALF * BK * 2  , STAGE_BYTES = 8 * HTB, NXCD = 8, WGM = 8;

#ifndef PG8_OLD_IMAGE
__host__ __device__ __forceinline__ int lds_byte(int r, int c) { return (r >> 3) * 1024 + (r & 7) * 128 + (((c >> 3) ^ ((r >> 1) & 7)) << 4) + (c & 7) * 2; }
__host__ __device__ __forceinline__ void stage_rc(int b, int& R, int& C) { const int st = b >> 10, sb = b & 1023, row = sb >> 7, chs = (sb >> 4) & 7; R = st * 8 + row; C = ((chs ^ ((R >> 1) & 7)) << 3) + ((sb & 15) >> 1); }
#else
__host__ __device__ __forceinline__ int lds_byte(int r, int c) { const int st = (r >> 4) * 2 + (c >> 5), rr = r & 15, cc = c & 31, ob = rr * 64 + cc * 2; return st * 1024 + (ob ^ (((ob >> 9) & 1) << 5)); }
__host__ __device__ __forceinline__ void stage_rc(int b, int& R, int& C) { const int st = b / 1024, sb = b % 1024, swz = sb ^ (((sb >> 9) & 1) << 5); R = (st >> 1) * 16 + swz / 64; C = (st & 1) * 32 + (swz % 64) / 2; }
#endif
__host__ __device__ __forceinline__ int perm32(int rho) { const int n = rho >> 4, i = rho & 15; return 8 * (i >> 2) + 4 * n + (i & 3); }

struct Unit { int pm, pn, hm, ui; };
struct Gemm { const bf16_t* A; const bf16_t* Bt; int lda; int K; int N; int a_pn_cols; };

struct StaticOrder {
    int nM, nN, nwg, G, c;
    __device__ void init(int M_, int N_, int G_, int c_) { nM = M_ / BM; nN = N_ / BM; nwg = nM * nN; G = G_; c = c_; }
    __device__ bool next(int i, Unit& u) const {
        const long L = (long)i * G + c; if (L >= nwg) return false;
        int wgid = (int)L; { const int q = nwg / NXCD, r = nwg % NXCD, xcd = wgid % NXCD, off = wgid / NXCD; wgid = (xcd < r ? xcd * (q + 1) : r * (q + 1) + (xcd - r) * q) + off; }
        const int nig = WGM * nN, gid = wgid / nig, fm = gid * WGM, gsz = (nM - fm) < WGM ? (nM - fm) : WGM;
        u.pm = fm + ((wgid % nig) % gsz); u.pn = (wgid % nig) / gsz; u.hm = -1; u.ui = i; return true;
    }
};
struct TailHalfOrder : StaticOrder {
    __device__ bool next(int i, Unit& u) const {
        const int full = nwg / G;
        if (i < full || 2 * (nwg % G) != G) return StaticOrder::next(i, u);
        if (i > full) return false;
        const int xcd = c % NXCD, k = c / NXCD, off = full * (G / NXCD) + (k >> 1);
        const int q = nwg / NXCD; int wgid = xcd * q + off;
        const int nig = WGM * nN, gid = wgid / nig, fm = gid * WGM, gsz = (nM - fm) < WGM ? (nM - fm) : WGM;
        u.pm = fm + ((wgid % nig) % gsz); u.pn = (wgid % nig) / gsz; u.hm = k & 1; u.ui = i; return true;
    }
};

struct EpiResid {
    static constexpr bool PERM = true; static constexpr bool RSTD_PRE = false;
    const bf16_t* XB; bf16_t* XBo; float* SS;
    float* fout; const float* gfin; float* slots; unsigned* cnt; int tid;
    __device__ __forceinline__ void operator()(const f32x4 (&acc)[2][2][4][2], const Unit& u, int wr, int wc, int fr, int fq) const {
        if (fout) { final_fused(acc, u, wr, wc, fr, fq); return; }
#pragma unroll
        for (int ai = 0; ai < 2; ++ai) rows(acc[ai], u, ai, wr, wc, fr, fq);
    }
    __device__ __forceinline__ void final_fused(const f32x4 (&acc)[2][2][4][2], const Unit& u, int wr, int wc, int fr, int fq) const {
        const int col0 = u.pn * BM + wc * 32 + 8 * fq;
        PG8_LAS float* P = (PG8_LAS float*)(131072 + 8192);
        PG8_LAS float* R = (PG8_LAS float*)(131072 + 8192 + 4096);
#pragma unroll
        for (int ai = 0; ai < 2; ++ai)
#pragma unroll
            for (int m = 0; m < 4; ++m) { const int rl = ai * HALF + wr * 64 + m * 16 + fr; const size_t off = (size_t)(u.pm * BM + rl) * D + col0; float ssq = 0.f;
#pragma unroll
                for (int bj = 0; bj < 2; ++bj) { const u32x4 b = *(const u32x4*)(XB + off + bj * HALF); const f32x4 a0 = acc[ai][bj][m][0], a1 = acc[ai][bj][m][1];
                    const float v0 = bf_lo(b.x) + a0.x, v1 = bf_hi(b.x) + a0.y, v2 = bf_lo(b.y) + a0.z, v3 = bf_hi(b.y) + a0.w, v4 = bf_lo(b.z) + a1.x, v5 = bf_hi(b.z) + a1.y, v6 = bf_lo(b.w) + a1.z, v7 = bf_hi(b.w) + a1.w;
                    ssq += ((v0 * v0 + v1 * v1) + (v2 * v2 + v3 * v3)) + ((v4 * v4 + v5 * v5) + (v6 * v6 + v7 * v7)); }
                ssq = xor32_sum(xor16_sum(ssq));
                if (fq == 0) P[rl * 4 + wc] = ssq; }
        asm volatile("s_waitcnt lgkmcnt(0)" ::: "memory"); __builtin_amdgcn_s_barrier(); asm volatile("" ::: "memory");
        if (tid < 256) { const float s = (P[tid * 4] + P[tid * 4 + 1]) + (P[tid * 4 + 2] + P[tid * 4 + 3]);
            __hip_atomic_store(slots + (size_t)(u.pm * BM + tid) * 4 + u.pn, s, __ATOMIC_RELAXED, __HIP_MEMORY_SCOPE_AGENT); }
        asm volatile("s_waitcnt vmcnt(0)" ::: "memory"); __builtin_amdgcn_s_barrier(); asm volatile("" ::: "memory");
        if (tid == 0) __hip_atomic_fetch_add(cnt + 64 * u.pm, 1u, __ATOMIC_RELAXED, __HIP_MEMORY_SCOPE_AGENT);
        if (tid < 64) { unsigned spins = 0;
            while ((unsigned)__builtin_amdgcn_readfirstlane((int)__hip_atomic_load(cnt + 64 * u.pm, __ATOMIC_RELAXED, __HIP_MEMORY_SCOPE_AGENT)) < 4u) { __builtin_amdgcn_s_sleep(2); if (++spins > (1u << 22)) break; } }
        asm volatile("s_waitcnt vmcnt(0) lgkmcnt(0)" ::: "memory"); __builtin_amdgcn_s_barrier(); asm volatile("" ::: "memory");
        if (tid < 256) { const float* sl = slots + (size_t)(u.pm * BM + tid) * 4; float s = 0.f;
#pragma unroll
            for (int t = 0; t < 4; ++t) s += __hip_atomic_load(sl + t, __ATOMIC_RELAXED, __HIP_MEMORY_SCOPE_AGENT);
            R[tid] = 1.0f / sqrtf(s * (1.0f / D) + EPS); }
        asm volatile("s_waitcnt vmcnt(0) lgkmcnt(0)" ::: "memory"); __builtin_amdgcn_s_barrier(); asm volatile("" ::: "memory");
        f32x4 g4[2][2];
#pragma unroll
        for (int bj = 0; bj < 2; ++bj) { g4[bj][0] = *(const f32x4*)(gfin + col0 + bj * HALF); g4[bj][1] = *(const f32x4*)(gfin + col0 + bj * HALF + 4); }
#pragma unroll
        for (int ai = 0; ai < 2; ++ai)
#pragma unroll
            for (int m = 0; m < 4; ++m) { const int rl = ai * HALF + wr * 64 + m * 16 + fr; const size_t off = (size_t)(u.pm * BM + rl) * D + col0; const float rs = R[rl];
#pragma unroll
                for (int bj = 0; bj < 2; ++bj) { const u32x4 b = *(const u32x4*)(XB + off + bj * HALF); const f32x4 a0 = acc[ai][bj][m][0], a1 = acc[ai][bj][m][1];
                    f32x4 o0, o1; o0.x = (bf_lo(b.x) + a0.x) * rs; o0.y = (bf_hi(b.x) + a0.y) * rs; o0.z = (bf_lo(b.y) + a0.z) * rs; o0.w = (bf_hi(b.y) + a0.w) * rs;
                    o1.x = (bf_lo(b.z) + a1.x) * rs; o1.y = (bf_hi(b.z) + a1.y) * rs; o1.z = (bf_lo(b.w) + a1.z) * rs; o1.w = (bf_hi(b.w) + a1.w) * rs;
                    __builtin_nontemporal_store(o0 * g4[bj][0], (f32x4*)(fout + off + bj * HALF)); __builtin_nontemporal_store(o1 * g4[bj][1], (f32x4*)(fout + off + bj * HALF + 4)); } }
    }
    __device__ __forceinline__ void rows(const f32x4 (&a)[2][4][2], const Unit& u, int ai, int wr, int wc, int fr, int fq) const {
        const int col0 = u.pn * BM + wc * 32 + 8 * fq;
        {
#ifdef EPI_BATCH
            u32x4 xb[4][2];
#pragma unroll
            for (int m = 0; m < 4; ++m)
#pragma unroll
                for (int bj = 0; bj < 2; ++bj) xb[m][bj] = *(const u32x4*)(XB + (size_t)(u.pm * BM + ai * HALF + wr * 64 + m * 16 + fr) * D + col0 + bj * HALF);
            __builtin_amdgcn_sched_barrier(0);
#endif
#pragma unroll
            for (int m = 0; m < 4; ++m) { const int row = u.pm * BM + ai * HALF + wr * 64 + m * 16 + fr; const size_t off = (size_t)row * D + col0; float ssq = 0.f;
#pragma unroll
                for (int bj = 0; bj < 2; ++bj) {
#ifdef EPI_BATCH
                    const u32x4 b = xb[m][bj];
#else
                    const u32x4 b = *(const u32x4*)(XB + off + bj * HALF);
#endif
                    const f32x4 a0 = a[bj][m][0], a1 = a[bj][m][1];
                    u32x4 w; w.x = cvtpk(bf_lo(b.x) + a0.x, bf_hi(b.x) + a0.y); w.y = cvtpk(bf_lo(b.y) + a0.z, bf_hi(b.y) + a0.w);
                    w.z = cvtpk(bf_lo(b.z) + a1.x, bf_hi(b.z) + a1.y); w.w = cvtpk(bf_lo(b.w) + a1.z, bf_hi(b.w) + a1.w);
                    *(u32x4*)(XBo + off + bj * HALF) = w;
                    const float r0 = bf_lo(w.x), r1 = bf_hi(w.x), r2 = bf_lo(w.y), r3 = bf_hi(w.y), r4 = bf_lo(w.z), r5 = bf_hi(w.z), r6 = bf_lo(w.w), r7 = bf_hi(w.w);
                    ssq += ((r0 * r0 + r1 * r1) + (r2 * r2 + r3 * r3)) + ((r4 * r4 + r5 * r5) + (r6 * r6 + r7 * r7)); }
                ssq = xor32_sum(xor16_sum(ssq));
                if (fq == 0) SS[(size_t)row * 16 + u.pn * 4 + wc] = ssq; }
        }
    }
};
constexpr int RSTD_TAB_OFF = 131072 + 4096, RSTD_SLOTS = 6;
struct RstdPre { f32x4 v[RSTD_SLOTS / 2][4]; bool ok[RSTD_SLOTS / 2]; };
template <class Sched> __device__ __forceinline__ void rstd_pre_load(RstdPre& P, const float* SS, const Sched& S, int wid, int tid) {
#pragma unroll
    for (int k = 0; k < RSTD_SLOTS / 2; ++k) { Unit t; P.ok[k] = S.next(2 * k + (wid >> 2), t); const int pm = P.ok[k] ? t.pm : 0;
        const f32x4* p = (const f32x4*)(SS + (size_t)(pm * BM + (tid & 255)) * 16);
#pragma unroll
        for (int q = 0; q < 4; ++q) P.v[k][q] = p[q]; }
}
__device__ __forceinline__ void rstd_pre_store(const RstdPre& P, int wid, int tid) {
    PG8_LAS float* tab = (PG8_LAS float*)(RSTD_TAB_OFF);
#pragma unroll
    for (int k = 0; k < RSTD_SLOTS / 2; ++k) { const f32x4 a = P.v[k][0], b = P.v[k][1], c = P.v[k][2], d = P.v[k][3];
        const float s = (((a.x + a.y) + (a.z + a.w)) + ((b.x + b.y) + (b.z + b.w))) + (((c.x + c.y) + (c.z + c.w)) + ((d.x + d.y) + (d.z + d.w)));
        if (P.ok[k]) tab[(2 * k + (wid >> 2)) * 256 + (tid & 255)] = 1.0f / sqrtf(s * (1.0f / D) + EPS); }
}
struct EpiSwiglu {
    static constexpr bool PERM = true; static constexpr bool RSTD_PRE = true;
    bf16_t* ACT; const float* SS; int tid; int skip;
    __device__ __forceinline__ void operator()(const f32x4 (&acc)[2][2][4][2], const Unit& u, int wr, int wc, int fr, int fq) const {
        if (skip && SS[0] != 123456.75f) return;
        const int col0 = u.pn * HALF + wc * 32 + 8 * fq;
        const PG8_LAS float* tab = (const PG8_LAS float*)(RSTD_TAB_OFF) + u.ui * 256;
        const int nai = u.hm < 0 ? 2 : 1, rb = u.hm < 0 ? 0 : u.hm * HALF;
#pragma unroll
        for (int ai = 0; ai < 2; ++ai) if (ai < nai)
#pragma unroll
            for (int m = 0; m < 4; ++m) { const int rl = rb + ai * HALF + wr * 64 + m * 16 + fr, row = u.pm * BM + rl; const float rs = tab[rl];
                const f32x4 g0 = acc[ai][0][m][0] * rs, g1 = acc[ai][0][m][1] * rs, u0 = acc[ai][1][m][0] * rs, u1 = acc[ai][1][m][1] * rs;
                const f32x4 x0 = g0 * -LOG2E, x1 = g1 * -LOG2E;
                f32x4 e0, e1; e0.x = __builtin_amdgcn_exp2f(x0.x); e0.y = __builtin_amdgcn_exp2f(x0.y); e0.z = __builtin_amdgcn_exp2f(x0.z); e0.w = __builtin_amdgcn_exp2f(x0.w);
                e1.x = __builtin_amdgcn_exp2f(x1.x); e1.y = __builtin_amdgcn_exp2f(x1.y); e1.z = __builtin_amdgcn_exp2f(x1.z); e1.w = __builtin_amdgcn_exp2f(x1.w);
                const f32x4 d0 = e0 + 1.0f, d1 = e1 + 1.0f;
                f32x4 r0, r1; r0.x = __builtin_amdgcn_rcpf(d0.x); r0.y = __builtin_amdgcn_rcpf(d0.y); r0.z = __builtin_amdgcn_rcpf(d0.z); r0.w = __builtin_amdgcn_rcpf(d0.w);
                r1.x = __builtin_amdgcn_rcpf(d1.x); r1.y = __builtin_amdgcn_rcpf(d1.y); r1.z = __builtin_amdgcn_rcpf(d1.z); r1.w = __builtin_amdgcn_rcpf(d1.w);
                const f32x4 o0 = (g0 * u0) * r0, o1 = (g1 * u1) * r1;
                u32x4 w; w.x = cvtpk(o0.x, o0.y); w.y = cvtpk(o0.z, o0.w); w.z = cvtpk(o1.x, o1.y); w.w = cvtpk(o1.z, o1.w);
                st16_wt(ACT + (size_t)row * DFF + col0, w); }
    }
};
struct EpiKVQ {
    static constexpr bool PERM = true; static constexpr bool RSTD_PRE = true;
    bf16_t* Kb; bf16_t* Qb; float* KMP; const float* SS; int pn_off; int tid;
    __device__ __forceinline__ void operator()(const f32x4 (&acc)[2][2][4][2], const Unit& u, int wr, int wc, int fr, int fq) const {
        const int tile = u.pn + pn_off, t = tile >> 2, col0 = (tile & 3) * BM + wc * 32 + 8 * fq;
        const PG8_LAS float* tab = (const PG8_LAS float*)(RSTD_TAB_OFF) + u.ui * 256;
        bf16_t* dst = (t == 2) ? Qb : Kb + (size_t)t * ((size_t)M * D);
#pragma unroll
        for (int ai = 0; ai < 2; ++ai) {
            f32x4 cs[2][2];
#pragma unroll
            for (int bj = 0; bj < 2; ++bj)
#pragma unroll
                for (int n = 0; n < 2; ++n) cs[bj][n] = (f32x4){0.f, 0.f, 0.f, 0.f};
#pragma unroll
            for (int m = 0; m < 4; ++m) { const int rl = ai * HALF + wr * 64 + m * 16 + fr, row = u.pm * BM + rl; const float rs = tab[rl];
#pragma unroll
                for (int bj = 0; bj < 2; ++bj) { const f32x4 v0 = acc[ai][bj][m][0] * rs, v1 = acc[ai][bj][m][1] * rs; cs[bj][0] = cs[bj][0] + v0; cs[bj][1] = cs[bj][1] + v1;
                    u32x4 w; w.x = cvtpk(v0.x, v0.y); w.y = cvtpk(v0.z, v0.w); w.z = cvtpk(v1.x, v1.y); w.w = cvtpk(v1.z, v1.w);
                    *(u32x4*)(dst + (size_t)row * D + col0 + bj * HALF) = w; } }
            if (t == 0) {
#pragma unroll
                for (int bj = 0; bj < 2; ++bj)
#pragma unroll
                    for (int n = 0; n < 2; ++n) { f32x4 c = cs[bj][n];
                        c.x = row16_sum(c.x); c.y = row16_sum(c.y); c.z = row16_sum(c.z); c.w = row16_sum(c.w);
                        if (fr == 0) *(f32x4*)(KMP + ((size_t)u.pm * 4 + 2 * ai + wr) * D + col0 + bj * HALF + 4 * n) = c; }
            }
        }
    }
};

template <class Epi, class Sched>
__device__ __forceinline__ void gemm_phase(PG8_LAS unsigned char* lds, const Gemm g, const Sched& S, const Epi& E, const int tid) {
    const int wid = __builtin_amdgcn_readfirstlane(tid >> 6), lane = tid & 63, wr = wid >> 2, wc = wid & 3, fr = lane & 15, fq = lane >> 4;
    const int K = g.K, nt = K / BK, lda = g.lda;
    unsigned voffA[2], voffB[2];
#pragma unroll
    for (int i = 0; i < 2; ++i) { int R, C; stage_rc(tid * 16 + i * 8192, R, C); const int Rb = Epi::PERM ? ((R & ~31) + perm32(R & 31)) : R;
        voffA[i] = (unsigned)(R * lda + C) * 2u; voffB[i] = (unsigned)(Rb * K + C) * 2u; }
    const size_t kstep = (size_t)(BK * 2);
    const size_t hstepA = (size_t)HALF * lda * 2, hstepB = (size_t)HALF * K * 2;
    const size_t tstepA = 2 * hstepA, tstepB = 2 * hstepB;
    const size_t pnA = (size_t)g.a_pn_cols * 2;
    const unsigned ldsw = (unsigned)wid * 1024u;
    const int aoff[2] = {lds_byte(wr * 64 + fr, fq * 8), lds_byte(wr * 64 + fr, fq * 8 + 32)}, boff[2] = {lds_byte(wc * 32 + fr, fq * 8), lds_byte(wc * 32 + fr, fq * 8 + 32)};
#define PG8_SA(b, h) (((b) * 2 + (h)) * HTB)
#define PG8_SB(b, h) ((4 + (b) * 2 + (h)) * HTB)
#define PG8_STAGE(bufoff, gbase, voff) do { _Pragma("unroll") for (int _i = 0; _i < 2; ++_i) \
        __builtin_amdgcn_global_load_lds((const unsigned*)((const char*)(gbase) + (voff)[_i]), (PG8_LAS unsigned*)(lds + (bufoff) + ldsw + _i * 8192), 16, 0, 0); } while (0)
#define PG8_LDA(dst, b, h) do { _Pragma("unroll") for (int m = 0; m < 4; ++m) _Pragma("unroll") for (int k = 0; k < 2; ++k) dst[m][k] = *(const PG8_LAS bf16x8*)(lds + PG8_SA(b, h) + aoff[k] + m * 2048); } while (0)
#define PG8_LDB(dst, b, h) do { _Pragma("unroll") for (int n = 0; n < 2; ++n) _Pragma("unroll") for (int k = 0; k < 2; ++k) dst[n][k] = *(const PG8_LAS bf16x8*)(lds + PG8_SB(b, h) + boff[k] + n * 2048); } while (0)
#define PG8_MMA(ai, bj, At, Bt) do { __builtin_amdgcn_s_setprio(1); _Pragma("unroll") for (int m = 0; m < 4; ++m) _Pragma("unroll") for (int n = 0; n < 2; ++n) _Pragma("unroll") for (int k = 0; k < 2; ++k) \
        acc[ai][bj][m][n] = __builtin_amdgcn_mfma_f32_16x16x32_bf16(Bt[n][k], At[m][k], acc[ai][bj][m][n], 0, 0, 0); __builtin_amdgcn_s_setprio(0); } while (0)
#define PG8_WAIT_V(n) asm volatile("s_waitcnt vmcnt(" #n ")" ::: "memory")
#define PG8_WAIT_L(n) asm volatile("s_waitcnt lgkmcnt(" #n ")" ::: "memory")
#define PG8_BAR __builtin_amdgcn_s_barrier()
#define PG8_SCHED __builtin_amdgcn_sched_barrier(0)
    Unit cur, nxt; int ui = 0;
    if (!S.next(0, cur)) return;
    RstdPre RP; if constexpr (Epi::RSTD_PRE) { rstd_pre_load(RP, E.SS, S, wid, tid); PG8_SCHED; }
    f32x4 acc[2][2][4][2];
#pragma unroll
    for (int a = 0; a < 2; ++a)
#pragma unroll
        for (int b = 0; b < 2; ++b)
#pragma unroll
            for (int m = 0; m < 4; ++m)
#pragma unroll
                for (int n = 0; n < 2; ++n) acc[a][b][m][n] = (f32x4){0.f, 0.f, 0.f, 0.f};
    bf16x8 At[4][2], B0[2][2], B1[2][2];
    const char* cA = (const char*)g.A + (size_t)cur.pm * tstepA + (size_t)cur.pn * pnA + (cur.hm > 0 ? hstepA : 0); const char* cB = (const char*)g.Bt + (size_t)cur.pn * tstepB;
    size_t chs = cur.hm < 0 ? hstepA : 0;
    PG8_STAGE(PG8_SB(0, 0), cB, voffB); PG8_STAGE(PG8_SB(0, 1), cB + hstepB, voffB); PG8_STAGE(PG8_SA(0, 0), cA, voffA); PG8_STAGE(PG8_SA(0, 1), cA + chs, voffA);
    if (wr == 1) PG8_BAR;
    PG8_WAIT_V(2); PG8_BAR;
    PG8_STAGE(PG8_SB(1, 0), cB + kstep, voffB); PG8_STAGE(PG8_SA(1, 0), cA + kstep, voffA); PG8_STAGE(PG8_SB(1, 1), cB + hstepB + kstep, voffB);
    PG8_WAIT_V(6); PG8_BAR;
    if constexpr (Epi::RSTD_PRE) { rstd_pre_store(RP, wid, tid); PG8_SCHED; }
    for (;;) {
        const bool has_next = S.next(ui + 1, nxt);
        const char* nA = has_next ? (const char*)g.A + (size_t)nxt.pm * tstepA + (size_t)nxt.pn * pnA + (nxt.hm > 0 ? hstepA : 0) : cA; const char* nB = has_next ? (const char*)g.Bt + (size_t)nxt.pn * tstepB : cB;
        const size_t nhs = has_next ? (nxt.hm < 0 ? hstepA : 0) : chs; const bool fullu = cur.hm < 0;
        for (int t = 0; t < nt; t += 2) {
            const bool last = (t == nt - 2);
            const char* a1 = cA + (size_t)(t + 1) * kstep;
            const char* a2 = last ? nA : cA + (size_t)(t + 2) * kstep; const char* b2 = last ? nB : cB + (size_t)(t + 2) * kstep;
            const char* a3 = a2 + kstep; const char* b3 = b2 + kstep;
            PG8_LDB(B0, 0, 0); PG8_LDB(B1, 0, 1); PG8_SCHED; PG8_LDA(At, 0, 0); PG8_STAGE(PG8_SA(1, 1), a1 + chs, voffA);
            PG8_WAIT_V(8); PG8_WAIT_L(0); PG8_BAR; PG8_MMA(0, 0, At, B0); PG8_MMA(0, 1, At, B1); PG8_BAR; PG8_SCHED;
            PG8_LDA(At, 0, 1); PG8_STAGE(PG8_SB(0, 0), b2, voffB); PG8_STAGE(PG8_SB(0, 1), b2 + hstepB, voffB); PG8_STAGE(PG8_SA(0, 0), a2, voffA);
            PG8_WAIT_V(8); PG8_WAIT_L(0); PG8_BAR; if (fullu) { PG8_MMA(1, 0, At, B0); PG8_MMA(1, 1, At, B1); } PG8_BAR; PG8_SCHED;
            PG8_LDB(B0, 1, 0); PG8_LDB(B1, 1, 1); PG8_SCHED; PG8_LDA(At, 1, 0); PG8_STAGE(PG8_SA(0, 1), a2 + (last ? nhs : chs), voffA);
            PG8_WAIT_V(8); PG8_WAIT_L(0); PG8_BAR; PG8_MMA(0, 0, At, B0); PG8_MMA(0, 1, At, B1); PG8_BAR; PG8_SCHED;
            PG8_LDA(At, 1, 1); PG8_STAGE(PG8_SB(1, 0), b3, voffB); PG8_STAGE(PG8_SB(1, 1), b3 + hstepB, voffB); PG8_STAGE(PG8_SA(1, 0), a3, voffA);
            PG8_WAIT_V(8); PG8_WAIT_L(0); PG8_BAR; if (fullu) { PG8_MMA(1, 0, At, B0); PG8_MMA(1, 1, At, B1); } PG8_BAR; PG8_SCHED;
        }
        if (wr == 0) PG8_BAR;
        E(acc, cur, wr, wc, fr, fq);
        if (!has_next) break;
#pragma unroll
        for (int a = 0; a < 2; ++a)
#pragma unroll
            for (int b = 0; b < 2; ++b)
#pragma unroll
                for (int m = 0; m < 4; ++m)
#pragma unroll
                    for (int n = 0; n < 2; ++n) acc[a][b][m][n] = (f32x4){0.f, 0.f, 0.f, 0.f};
        cur = nxt; cA = nA; cB = nB; chs = nhs; ++ui;
        if (wr == 1) PG8_BAR;
    }
    PG8_WAIT_V(0);
    PG8_BAR;
#undef PG8_SA
#undef PG8_SB
#undef PG8_STAGE
#undef PG8_LDA
#undef PG8_LDB
#undef PG8_MMA
#undef PG8_WAIT_V
#undef PG8_WAIT_L
#undef PG8_BAR
#undef PG8_SCHED
}
}
namespace poolf {
using namespace pg8;
template <int W> __device__ __forceinline__ void build_d(PG8_LAS unsigned char* lds, const bf16_t* X, const float* SS, int pm, int g, int ai, int wid, int lane) {
    constexpr int NR = 16 + W - 1;
    const int hw = lane >> 5, l32 = lane & 31;
    const int bq = pm >> 3, t0 = (pm & 7) * 256 + 128 * ai + 16 * wid;
    const int c0 = 256 * g + 128 * hw + 4 * l32;
    float rs = 0.f; { const int t = t0 - (W - 1) + l32; if (l32 < NR && t >= 0) rs = row_rstd(SS, bq * SEQ + t); }
    f32x4 v[NR]; u32x2 wraw[NR];
#pragma unroll
    for (int i = 0; i < NR; ++i) { const int t = t0 - (W - 1) + i, tc = t < 0 ? 0 : t;
        wraw[i] = *(const u32x2*)(X + (size_t)(bq * SEQ + tc) * D + c0); }
    __builtin_amdgcn_sched_barrier(0);
#pragma unroll
    for (int i = 0; i < NR; ++i) { const float r = lane_bcast(rs, i); v[i] = (f32x4){bf_lo(wraw[i].x), bf_hi(wraw[i].x), bf_lo(wraw[i].y), bf_hi(wraw[i].y)} * r; }
    f32x4 S = (f32x4){0.f, 0.f, 0.f, 0.f};
#pragma unroll
    for (int i = 0; i < W - 1; ++i) S = S + v[i];
    const int kt = 2 * hw + (l32 >> 4), cc = (4 * l32) & 63;
#pragma unroll
    for (int r = 0; r < 16; ++r) { const int i = r + W - 1; S = S + v[i]; const int t = t0 + r; const float cnt = (float)((t + 1) < W ? (t + 1) : W);
        const f32x4 d = S * __builtin_amdgcn_rcpf(cnt) - v[i];     u32x2 w; w.x = cvtpk(d.x, d.y); w.y = cvtpk(d.z, d.w);
        *(PG8_LAS u32x2*)(lds + kt * HTB + lds_byte(16 * wid + r, cc)) = w; S = S - v[r]; }
}
__device__ __forceinline__ void build_d_dispatch(PG8_LAS unsigned char* lds, const bf16_t* X, const float* SS, int pm, int g, int ai, int wid, int lane) {
    if (g == 0) build_d<2>(lds, X, SS, pm, 0, ai, wid, lane); else if (g == 1) build_d<4>(lds, X, SS, pm, 1, ai, wid, lane);
    else if (g == 2) build_d<8>(lds, X, SS, pm, 2, ai, wid, lane); else build_d<16>(lds, X, SS, pm, 3, ai, wid, lane);
}
__device__ __forceinline__ void pool_phase(PG8_LAS unsigned char* lds, const bf16_t* XB, const float* SS, const bf16_t* Wp, const StaticOrder& S, const EpiResid& E, const int tid) {
    const int wid = __builtin_amdgcn_readfirstlane(tid >> 6), lane0 = tid & 63, wr = wid >> 2, wc = wid & 3;
    constexpr int K = 256;
    const unsigned ldsw = (unsigned)wid * 1024u;
    Unit u;
    for (int ui = 0; S.next(ui, u); ++ui) {
        const char* cB = (const char*)Wp + (size_t)u.pn * 256 * K * 2;
        for (int ai = 0; ai < 2; ++ai) {
            int lane = lane0; asm volatile("" : "+v"(lane)); const int fr = lane & 15, fq = lane >> 4, tidl = wid * 64 + lane;
            unsigned voffB[2];
#pragma unroll
            for (int i = 0; i < 2; ++i) { int R, C; stage_rc(tidl * 16 + i * 8192, R, C); const int Rb = (R & ~31) + perm32(R & 31); voffB[i] = (unsigned)(Rb * K + C) * 2u; }
#pragma unroll
            for (int kt = 0; kt < 4; ++kt)
#pragma unroll
                for (int i = 0; i < 2; ++i)
                    __builtin_amdgcn_global_load_lds((const unsigned*)(cB + (size_t)kt * (BK * 2) + voffB[i]), (PG8_LAS unsigned*)(lds + (4 + kt) * HTB + ldsw + i * 8192), 16, 0, 0);
            build_d_dispatch(lds, XB, SS, u.pm, u.pn, ai, wid, lane);
            const int aoff[2] = {lds_byte(wr * 64 + fr, fq * 8), lds_byte(wr * 64 + fr, fq * 8 + 32)}, boff[2] = {lds_byte(wc * 32 + fr, fq * 8), lds_byte(wc * 32 + fr, fq * 8 + 32)};
            f32x4 acc[2][4][2];
#pragma unroll
            for (int bj = 0; bj < 2; ++bj) {
                if (bj == 1) {
#pragma unroll
                    for (int kt = 0; kt < 4; ++kt)
#pragma unroll
                        for (int i = 0; i < 2; ++i)
                            __builtin_amdgcn_global_load_lds((const unsigned*)(cB + (size_t)HALF * K * 2 + (size_t)kt * (BK * 2) + voffB[i]), (PG8_LAS unsigned*)(lds + (4 + kt) * HTB + ldsw + i * 8192), 16, 0, 0);
                }
                asm volatile("s_waitcnt vmcnt(0) lgkmcnt(0)" ::: "memory"); __builtin_amdgcn_s_barrier(); asm volatile("" ::: "memory");
#pragma unroll
                for (int m = 0; m < 4; ++m)
#pragma unroll
                    for (int n = 0; n < 2; ++n) acc[bj][m][n] = (f32x4){0.f, 0.f, 0.f, 0.f};
#pragma unroll
                for (int kt = 0; kt < 4; ++kt) {
                    bf16x8 At[4][2], Bt[2][2];
#pragma unroll
                    for (int n = 0; n < 2; ++n)
#pragma unroll
                        for (int k = 0; k < 2; ++k) Bt[n][k] = *(const PG8_LAS bf16x8*)(lds + (4 + kt) * HTB + boff[k] + n * 2048);
#pragma unroll
                    for (int m = 0; m < 4; ++m)
#pragma unroll
                        for (int k = 0; k < 2; ++k) At[m][k] = *(const PG8_LAS bf16x8*)(lds + kt * HTB + aoff[k] + m * 2048);
#pragma unroll
                    for (int m = 0; m < 4; ++m)
#pragma unroll
                        for (int n = 0; n < 2; ++n)
#pragma unroll
                            for (int k = 0; k < 2; ++k) acc[bj][m][n] = __builtin_amdgcn_mfma_f32_16x16x32_bf16(Bt[n][k], At[m][k], acc[bj][m][n], 0, 0, 0);
                }
                asm volatile("s_waitcnt lgkmcnt(0)" ::: "memory"); __builtin_amdgcn_s_barrier(); asm volatile("" ::: "memory");
            }
            E.rows(acc, u, ai, wr, wc, fr, fq);
        }
    }
}
}
#include <hip/hip_bf16.h>
#include <cmath>
namespace attn_body {
using bf16=__hip_bfloat16;
using bf16x8=__attribute__((ext_vector_type(8)))short;
using s16x4=__attribute__((ext_vector_type(4)))short;
using f32x16=__attribute__((ext_vector_type(16)))float;
using u32x4=__attribute__((ext_vector_type(4)))unsigned;
using f32x4=__attribute__((ext_vector_type(4)))float;
constexpr int NHEAD=16,SEQ=2048,D=64,DM=NHEAD*D;
constexpr int NW=8,QBLK=32,QB=QBLK*NW,KVBLK=64;
__device__ __forceinline__ int crow(int r,int hi){return (r&3)+8*(r>>2)+4*hi;}
#define SBAR() __builtin_amdgcn_sched_barrier(0)
typedef __attribute__((address_space(3))) const float* lds_fptr;
__device__ __forceinline__ void bias_load(f32x16&b0,f32x16&b1,int dl,int hi,lds_fptr bt){
  const lds_fptr pb=bt+(dl-4*hi+69);
  #pragma unroll
  for(int r=0;r<16;++r){ const int c=(r&3)+8*(r>>2); b0[r]=pb[59-c]; b1[r]=pb[27-c]; }
}

constexpr int NSLOT=3, SLOTB=8192;
constexpr int LDS_K=0, LDS_V=NSLOT*SLOTB, LDS_WS=2*NSLOT*SLOTB, LDS_OST=LDS_WS+NW*64*4, LDS_BT=LDS_OST+NW*4096, LDS_KM=LDS_BT+2560, LDS_QP=LDS_KM+2048, LDS_BYTES=LDS_QP+4*8192;
__device__ __forceinline__ void glds16(const void*sbase,unsigned voff,unsigned lds_dst){unsigned keep;
  asm volatile("s_mov_b32 %0, m0\n\ts_mov_b32 m0, %3\n\ts_nop 0\n\tglobal_load_lds_dwordx4 %1, %2\n\ts_mov_b32 m0, %0":"=&s"(keep):"v"(voff),"s"(sbase),"s"(lds_dst):"memory");}
__device__ __forceinline__ float max3f(float a,float b,float c){float r;asm("v_max3_f32 %0, %1, %2, %3":"=v"(r):"v"(a),"v"(b),"v"(c));return r;}
__device__ __forceinline__ float max2f(float a,float b){float r;asm("v_max_f32_e32 %0, %1, %2":"=v"(r):"v"(a),"v"(b));return r;}
__device__ __forceinline__ float fadd_s(float a,float b){float r;asm("v_add_f32_e32 %0, %1, %2":"=v"(r):"v"(a),"v"(b));return r;}
__device__ __forceinline__ float fsub_s(float a,float b){float r;asm("v_sub_f32_e32 %0, %1, %2":"=v"(r):"v"(a),"v"(b));return r;}
typedef float f32x2_t __attribute__((ext_vector_type(2))); typedef __bf16 bf16x2_t __attribute__((ext_vector_type(2)));
__device__ __forceinline__ unsigned cvtpk_s(float lo,float hi){f32x2_t v={lo,hi};bf16x2_t b=__builtin_convertvector(v,bf16x2_t);return __builtin_bit_cast(unsigned,b);}
#define WAIT_BAR(N) asm volatile("s_waitcnt vmcnt(" #N ") lgkmcnt(0)\n\ts_barrier":::"memory")

__device__ __forceinline__ void qkt(f32x16&p0,f32x16&p1,const char*Kslot,const bf16x8*qr,const f32x16 i0,const f32x16 i1,int r32,int hi){
  const char*kb=Kslot+hi*1024+r32*16;
  #pragma unroll
  for(int d0=0;d0<4;++d0){
    const bf16x8 b0=*reinterpret_cast<const bf16x8*>(kb+d0*2048);
    const bf16x8 b1=*reinterpret_cast<const bf16x8*>(kb+d0*2048+512);
    if(d0==0){p0=__builtin_amdgcn_mfma_f32_32x32x16_bf16(b0,qr[0],i0,0,0,0);p1=__builtin_amdgcn_mfma_f32_32x32x16_bf16(b1,qr[0],i1,0,0,0);}
    else{p0=__builtin_amdgcn_mfma_f32_32x32x16_bf16(b0,qr[d0],p0,0,0,0);p1=__builtin_amdgcn_mfma_f32_32x32x16_bf16(b1,qr[d0],p1,0,0,0);}}
}
typedef __attribute__((address_space(3))) const char* lds_cptr;
typedef short v4i16_t __attribute__((ext_vector_type(4)));
__device__ __forceinline__ void kload8(bf16x8*kf,lds_cptr kp){
  kf[0]=*(const __attribute__((address_space(3))) bf16x8*)(kp);      kf[1]=*(const __attribute__((address_space(3))) bf16x8*)(kp+512);
  kf[2]=*(const __attribute__((address_space(3))) bf16x8*)(kp+2048); kf[3]=*(const __attribute__((address_space(3))) bf16x8*)(kp+2560);
  kf[4]=*(const __attribute__((address_space(3))) bf16x8*)(kp+4096); kf[5]=*(const __attribute__((address_space(3))) bf16x8*)(kp+4608);
  kf[6]=*(const __attribute__((address_space(3))) bf16x8*)(kp+6144); kf[7]=*(const __attribute__((address_space(3))) bf16x8*)(kp+6656);
}
__device__ __forceinline__ void kload2(bf16x8*kf,lds_cptr kp,int j){ kf[2*j]=*(const __attribute__((address_space(3))) bf16x8*)(kp+j*2048); kf[2*j+1]=*(const __attribute__((address_space(3))) bf16x8*)(kp+j*2048+512); }
__device__ __forceinline__ s16x4 vtr(lds_cptr p){ return __builtin_bit_cast(s16x4,__builtin_amdgcn_ds_read_tr16_b64_v4i16((__attribute__((address_space(3))) v4i16_t*)p)); }
__device__ __forceinline__ float rowmax(const f32x16&p0,const f32x16&p1){
  float a=max3f(p0[0],p0[1],p1[0]),b=max3f(p0[2],p0[3],p1[1]);a=max3f(a,p1[2],p1[3]);
  #pragma unroll
  for(int r=4;r<16;r+=4){a=max3f(a,p0[r],p0[r+1]);b=max3f(b,p0[r+2],p0[r+3]);a=max3f(a,p1[r],p1[r+1]);b=max3f(b,p1[r+2],p1[r+3]);}
  const float m=max2f(a,b);
  auto rr=__builtin_amdgcn_permlane32_swap(__float_as_uint(m),__float_as_uint(m),false,false);
  return max2f(__uint_as_float(rr[0]),__uint_as_float(rr[1]));
}
__device__ __forceinline__ void pv(f32x16*o,int vb,bf16x8 pa0,bf16x8 pa1,bf16x8 pa2,bf16x8 pa3){
  #pragma unroll
  for(int d0=0;d0<2;++d0){s16x4 lo[4],hi[4];
    #pragma unroll
    for(int ks=0;ks<4;++ks){
      asm volatile("ds_read_b64_tr_b16 %0,%1 offset:%c2":"=&v"(lo[ks]):"v"(vb),"i"(d0*4096+ks*1024):"memory");
      asm volatile("ds_read_b64_tr_b16 %0,%1 offset:%c2":"=&v"(hi[ks]):"v"(vb),"i"(d0*4096+ks*1024+512):"memory");}
    asm volatile("s_waitcnt lgkmcnt(0)":::"memory");SBAR();
    #define PK(k) (bf16x8){lo[k][0],lo[k][1],lo[k][2],lo[k][3],hi[k][0],hi[k][1],hi[k][2],hi[k][3]}
    o[d0]=__builtin_amdgcn_mfma_f32_32x32x16_bf16(pa0,PK(0),o[d0],0,0,0);
    o[d0]=__builtin_amdgcn_mfma_f32_32x32x16_bf16(pa1,PK(1),o[d0],0,0,0);
    o[d0]=__builtin_amdgcn_mfma_f32_32x32x16_bf16(pa2,PK(2),o[d0],0,0,0);
    o[d0]=__builtin_amdgcn_mfma_f32_32x32x16_bf16(pa3,PK(3),o[d0],0,0,0);
    #undef PK
  }
}

#ifndef ATTN_STORE16
#define ATTN_STORE16(p,v) (*(u32x4*)(p)=(v))
#endif
template<int THRL,bool NOFIX=false> __device__ __forceinline__ void attn_unit(int b,int h,int own,const bf16*Q,const bf16*__restrict__ K,const bf16*__restrict__ V,bf16*O,const float*KMP,const float*biasT,char*shm,const int wid){
  int lane=__builtin_amdgcn_mbcnt_hi(~0u,__builtin_amdgcn_mbcnt_lo(~0u,0u)); asm volatile("":"+v"(lane));
  const int tid=wid*64+lane,r32=lane&31,hi=lane>>5;
  const long rowbase=(long)b*SEQ; const int q0=own*QB;
  const bf16*Qw=Q+(rowbase+q0+wid*QBLK)*DM+h*D;
  const bf16*Kh=K+rowbase*DM+h*D,*Vh=V+rowbase*DM+h*D;
  const unsigned lds0=(unsigned)(uintptr_t)shm;
  float*wsf=(float*)(shm+LDS_WS)+wid*64;
  const lds_cptr shm3=(lds_cptr)shm;
  const lds_fptr bt=(lds_fptr)(shm3+LDS_BT);
  const lds_fptr km=(lds_fptr)(shm3+LDS_KM);
  { typedef __attribute__((address_space(3))) float* lds_wptr; const lds_wptr btw=(lds_wptr)(shm3+LDS_BT), kmw=(lds_wptr)(shm3+LDS_KM);
    for(int e=tid;e<640;e+=512){ const int d=e-128; btw[e]=d<0?-INFINITY:(d<128?biasT[h*128+d]:0.f); }
    const int j=tid>>6,d=tid&63;
    if(j<own){ const float*kp=KMP+((size_t)(b*8+j)*4)*1024+h*64+d; kmw[j*64+d]=(kp[0]+kp[1024])+(kp[2048]+kp[3072]); } }
  #define KT(i) (((i)<4)?(4*own+(i)):((i)-4))
  const unsigned koff=(unsigned)(lane*DM+wid*8)*2u;
  const unsigned voff=(unsigned)((16*(wid&3)+(lane>>2))*DM+(wid>>2)*32+(lane&3)*8)*2u;
  const unsigned kdst=lds0+LDS_K+wid*1024, vdst=lds0+LDS_V+wid*1024;
  #define DMA_K(t,slot) glds16(Kh+(long)KT(t)*KVBLK*DM,koff,(unsigned)__builtin_amdgcn_readfirstlane(kdst+(slot)))
  #define DMA_V(t,slot) glds16(Vh+(long)KT(t)*KVBLK*DM,voff,(unsigned)__builtin_amdgcn_readfirstlane(vdst+(slot)))
  const char*Kbase=shm+LDS_K; bf16x8 kf[8];
  const lds_cptr kp0=shm3+LDS_K+hi*1024+r32*16; const lds_cptr vp0=shm3+LDS_V+((lane>>4)&1)*32+(lane&3)*8+(4*hi+((lane&15)>>2))*64;
  const int NT=4*own+4;
  DMA_K(0,0);DMA_V(0,0);DMA_K(1,SLOTB);
  bf16x8 qr[4];
  #pragma unroll
  for(int d0=0;d0<4;++d0)qr[d0]=__builtin_nontemporal_load(reinterpret_cast<const bf16x8*>(&Qw[(long)r32*DM+d0*16+hi*8]));
  float mhat=0.f,l_reg=0.f;f32x16 o[2];o[0]=f32x16{};o[1]=f32x16{};const f32x16 zero16=f32x16{};
  #define qrel (wid*QBLK+r32)
  unsigned selmask=(own<=3)?((1u<<own)-1u):0u;
  #define KEEPF(t,KEEP) do{ if(NOFIX)break; const int t_=(t); \
      if(t_<4){ if(64*t_>32*wid+31) KEEP=false; } else { KEEP=(selmask>>((t_-4)>>2))&1u; } }while(0)
  #define NEEDB(t,NB,B0,B1) do{ NB=false; if(NOFIX)break; const int t_=(t); int dl_=0; \
      if(t_<4){ if(64*t_<=32*wid+31&&32*wid-64*t_-63<113){ NB=true; dl_=qrel-64*t_; } } \
      else if(t_<NT){ const int j_=(t_-4)>>2, tt_=(t_-4)&3; if(j_==own-1&&(256+32*wid-64*tt_-63<113)){ NB=true; dl_=256+qrel-64*tt_; } } \
      if(NB) bias_load(B0,B1,dl_,hi,bt); }while(0)
  bool resc=false;
  #define START(P0,P1) do{ const float rm=rowmax(P0,P1); resc=false; \
    { const float dl=rm; mhat=fadd_s(mhat,dl); \
      _Pragma("unroll") for(int r=0;r<16;++r){P0[r]=fsub_s(P0[r],dl);P1[r]=fsub_s(P1[r],dl);} } \
    _Pragma("unroll") for(int r=0;r<16;++r)P0[r]=__builtin_amdgcn_exp2f(P0[r]); }while(0)
  #define RESC() do{ if(resc){ asm volatile("s_waitcnt lgkmcnt(0)":::"memory"); \
      _Pragma("unroll") for(int d_=0;d_<2;++d_) _Pragma("unroll") for(int r=0;r<16;++r)o[d_][r]*=wsf[crow(r,hi)]; } }while(0)
  int sl_prev=0,sl_cur=0,sl_next=SLOTB;
  #define ROT() do{sl_prev=sl_cur;sl_cur=sl_next;sl_next=(sl_next==(NSLOT-1)*SLOTB)?0:sl_next+SLOTB;}while(0)
  DMA_K(2,2*SLOTB);
  WAIT_BAR(3);
  if(own>=4){
    float b0=-INFINITY,b1=-INFINITY,b2=-INFINITY; int i0=0,i1=0,i2=0;
    for(int j=0;j<own;++j){ float g=0.f;
      #pragma unroll
      for(int d0=0;d0<4;++d0){ const f32x4 ka=*(const __attribute__((address_space(3))) f32x4*)(km+j*64+d0*16+hi*8), kb2=*(const __attribute__((address_space(3))) f32x4*)(km+j*64+d0*16+hi*8+4);
        const bf16x8 qv=qr[d0];
        g+=__uint_as_float((unsigned)(unsigned short)qv[0]<<16)*ka.x; g+=__uint_as_float((unsigned)(unsigned short)qv[1]<<16)*ka.y; g+=__uint_as_float((unsigned)(unsigned short)qv[2]<<16)*ka.z; g+=__uint_as_float((unsigned)(unsigned short)qv[3]<<16)*ka.w;
        g+=__uint_as_float((unsigned)(unsigned short)qv[4]<<16)*kb2.x; g+=__uint_as_float((unsigned)(unsigned short)qv[5]<<16)*kb2.y; g+=__uint_as_float((unsigned)(unsigned short)qv[6]<<16)*kb2.z; g+=__uint_as_float((unsigned)(unsigned short)qv[7]<<16)*kb2.w; }
      { auto rr=__builtin_amdgcn_permlane32_swap(__float_as_uint(g),__float_as_uint(g),false,false); g=__uint_as_float(rr[0])+__uint_as_float(rr[1]); }
      if(g>b0){b2=b1;i2=i1;b1=b0;i1=i0;b0=g;i0=j;} else if(g>b1){b2=b1;i2=i1;b1=g;i1=j;} else if(g>b2){b2=g;i2=j;} }
    selmask=(1u<<i0)|(1u<<i1)|(1u<<i2);
  }
  #define PKW(P,B) cvtpk_s(P[B],P[B+1])
  #define PK4(P,B) (u32x4){PKW(P,B),PKW(P,B+2),PKW(P,B+4),PKW(P,B+6)}
  u32x4 pwA0,pwA1,pwA2,pwA3,pwB0,pwB1,pwB2,pwB3;
  { f32x16 c0,c1;
    bool nb0_; NEEDB(0,nb0_,c0,c1); if(!nb0_){c0=zero16;c1=zero16;}
    qkt(c0,c1,Kbase,qr,c0,c1,r32,hi);asm volatile("s_nop 15\n\ts_nop 7":"+v"(c0),"+v"(c1));
    START(c0,c1);
    _Pragma("unroll") for(int r=0;r<16;++r)c1[r]=__builtin_amdgcn_exp2f(c1[r]);
    float sacc=c0[0]+c0[1]; _Pragma("unroll") for(int r=2;r<16;++r)sacc+=c0[r]; _Pragma("unroll") for(int r=0;r<16;++r)sacc+=c1[r]; l_reg+=sacc;
    pwA0=PK4(c0,0);pwA1=PK4(c0,8);pwA2=PK4(c1,0);pwA3=PK4(c1,8); }
  const __attribute__((address_space(3))) bf16x8* qlp=(const __attribute__((address_space(3))) bf16x8*)(shm3+LDS_QP)+tid;
  { __attribute__((address_space(3))) bf16x8* qw=(__attribute__((address_space(3))) bf16x8*)(shm3+LDS_QP)+tid;
    _Pragma("unroll") for(int d0=0;d0<4;++d0) qw[d0*512]=qr[d0]; }
  #define QL(d0) qlp[(d0)*512]
  bf16x8 qa=QL(0),qb=QL(1);
  WAIT_BAR(0);
  DMA_K(3,0);DMA_V(1,SLOTB);
  ROT();
  kload8(kf,kp0+sl_cur);
  WAIT_BAR(2);
  s16x4 vlo[8],vhi[8];
  #define PAFV(v) __builtin_bit_cast(bf16x8,v)
  #define VFR(i) (bf16x8){vlo[i][0],vlo[i][1],vlo[i][2],vlo[i][3],vhi[i][0],vhi[i][1],vhi[i][2],vhi[i][3]}
  #define PIN(x) asm volatile("":"+v"(x))
  #define MX3(a,b,c) __builtin_fmaxf(__builtin_fmaxf((a),(b)),(c))
  #define GAPA(MF) do{ MF; SBAR(); }while(0)
  #define EX(v) __builtin_amdgcn_exp2f(v)
  #define GAPB(MF,X,B,PK) do{ MF; X[B]=EX(X[B]); X[B+1]=EX(X[B+1]); X[B+2]=EX(X[B+2]); X[B+3]=EX(X[B+3]); sacc+=X[B]; sacc+=X[B+1]; sacc+=X[B+2]; sacc+=X[B+3]; PIN(sacc); PIN(X); PK; SBAR(); }while(0)
  #define VRD(i) do{ vlo[i]=vtr(vp_+(((i)>>2)*4096+((i)&3)*1024)); vhi[i]=vtr(vp_+(((i)>>2)*4096+((i)&3)*1024+512)); }while(0)
  #define KRD(j) do{ kload2(kf,kp0+sl_next,j); SBAR(); }while(0)
  #define STEP(I0,I1,I2,I3,O0,O1,O2,O3,t,GK,GV) do{ SBAR(); \
    const lds_cptr vp_=vp0+sl_prev; f32x16 C0,C1; bool nb; NEEDB(t,nb,C0,C1); \
    VRD(0); SBAR(); \
    if(nb){ GAPA(C0=__builtin_amdgcn_mfma_f32_32x32x16_bf16(kf[0],qa,C0,0,0,0)); VRD(4); SBAR(); GAPA(C1=__builtin_amdgcn_mfma_f32_32x32x16_bf16(kf[1],qa,C1,0,0,0)); } \
    else  { GAPA(C0=__builtin_amdgcn_mfma_f32_32x32x16_bf16(kf[0],qa,zero16,0,0,0)); VRD(4); SBAR(); GAPA(C1=__builtin_amdgcn_mfma_f32_32x32x16_bf16(kf[1],qa,zero16,0,0,0)); } \
    qa=QL(2); VRD(1); SBAR(); GAPA(C0=__builtin_amdgcn_mfma_f32_32x32x16_bf16(kf[2],qb,C0,0,0,0)); \
    VRD(5); SBAR(); GAPA(C1=__builtin_amdgcn_mfma_f32_32x32x16_bf16(kf[3],qb,C1,0,0,0)); \
    qb=QL(3); VRD(2); SBAR(); GAPA(C0=__builtin_amdgcn_mfma_f32_32x32x16_bf16(kf[4],qa,C0,0,0,0)); \
    VRD(6); SBAR(); GAPA(C1=__builtin_amdgcn_mfma_f32_32x32x16_bf16(kf[5],qa,C1,0,0,0)); \
    VRD(3); SBAR(); GAPA(C0=__builtin_amdgcn_mfma_f32_32x32x16_bf16(kf[6],qb,C0,0,0,0)); \
    VRD(7); SBAR(); GAPA(C1=__builtin_amdgcn_mfma_f32_32x32x16_bf16(kf[7],qb,C1,0,0,0)); \
    if(GK){DMA_K((t)+3,sl_cur);} if(GV){DMA_V((t)+1,sl_next);} \
    bool keep_=true; KEEPF(t,keep_); \
    { float a=MX3(C0[0],C0[1],C1[0]),b=MX3(C0[2],C0[3],C1[1]); a=MX3(a,C1[2],C1[3]); \
      _Pragma("unroll") for(int r=4;r<16;r+=4){a=MX3(a,C0[r],C0[r+1]);b=MX3(b,C0[r+2],C0[r+3]);a=MX3(a,C1[r],C1[r+1]);b=MX3(b,C1[r+2],C1[r+3]);} \
      float rm=__builtin_fmaxf(a,b); { auto rr=__builtin_amdgcn_permlane32_swap(__float_as_uint(rm),__float_as_uint(rm),false,false); rm=__builtin_fmaxf(__uint_as_float(rr[0]),__uint_as_float(rr[1])); } \
      rm=keep_?rm-mhat:-INFINITY; resc=false; \
      if(__builtin_expect(__any(rm>(float)THRL),0)){ const float dl=__builtin_fmaxf(rm,0.f); mhat+=dl; \
        const float f=__builtin_amdgcn_exp2f(-dl); l_reg*=f; if(hi==0)wsf[r32]=f; resc=true; } \
      const float msub=keep_?mhat:INFINITY; \
      _Pragma("unroll") for(int r=0;r<16;++r){C0[r]-=msub;C1[r]-=msub;} } \
    SBAR(); float sacc=0.f; \
    GAPB(o[0]=__builtin_amdgcn_mfma_f32_32x32x16_bf16(PAFV(I0),VFR(0),o[0],0,0,0), C0,0, ); \
    GAPB(o[1]=__builtin_amdgcn_mfma_f32_32x32x16_bf16(PAFV(I0),VFR(4),o[1],0,0,0), C0,4, ); \
    KRD(0); GAPB(o[0]=__builtin_amdgcn_mfma_f32_32x32x16_bf16(PAFV(I1),VFR(1),o[0],0,0,0), C0,8,  O0[0]=PKW(C0,0);O0[1]=PKW(C0,2);PIN(O0)); \
    KRD(1); GAPB(o[1]=__builtin_amdgcn_mfma_f32_32x32x16_bf16(PAFV(I1),VFR(5),o[1],0,0,0), C0,12, O0[2]=PKW(C0,4);O0[3]=PKW(C0,6);PIN(O0)); \
    KRD(2); GAPB(o[0]=__builtin_amdgcn_mfma_f32_32x32x16_bf16(PAFV(I2),VFR(2),o[0],0,0,0), C1,0,  O1[0]=PKW(C0,8);O1[1]=PKW(C0,10);PIN(O1)); \
    KRD(3); GAPB(o[1]=__builtin_amdgcn_mfma_f32_32x32x16_bf16(PAFV(I2),VFR(6),o[1],0,0,0), C1,4,  O1[2]=PKW(C0,12);O1[3]=PKW(C0,14);PIN(O1)); \
    GAPB(o[0]=__builtin_amdgcn_mfma_f32_32x32x16_bf16(PAFV(I3),VFR(3),o[0],0,0,0), C1,8,  O2[0]=PKW(C1,0);O2[1]=PKW(C1,2);PIN(O2)); \
    GAPB(o[1]=__builtin_amdgcn_mfma_f32_32x32x16_bf16(PAFV(I3),VFR(7),o[1],0,0,0), C1,12, O2[2]=PKW(C1,4);O2[3]=PKW(C1,6);PIN(O2)); \
    O3=PK4(C1,8); l_reg+=sacc; qa=QL(0); qb=QL(1); \
    }while(0)
  #define ENDW(tt) do{ if((tt)+3<NT){WAIT_BAR(2);} else if((tt)+2<NT){WAIT_BAR(1);} else {WAIT_BAR(0);} }while(0)
  int t=1;
  for(;t+1<NT;t+=2){
    STEP(pwA0,pwA1,pwA2,pwA3,pwB0,pwB1,pwB2,pwB3,t,(t+3<NT),(t+1<NT));       ENDW(t);   RESC(); ROT();
    STEP(pwB0,pwB1,pwB2,pwB3,pwA0,pwA1,pwA2,pwA3,t+1,(t+4<NT),(t+2<NT));     ENDW(t+1); RESC(); ROT();
  }
  STEP(pwA0,pwA1,pwA2,pwA3,pwB0,pwB1,pwB2,pwB3,NT-1,false,false); RESC();
  { SBAR(); pv(o,(int)(unsigned)(uintptr_t)(vp0+sl_cur),PAFV(pwB0),PAFV(pwB1),PAFV(pwB2),PAFV(pwB3)); }
  #undef PK4
  #undef QL
  #undef PAFV
  #undef PKW
  #undef VFR
  #undef PIN
  #undef MX3
  #undef GAPA
  #undef GAPB
  #undef EX
  #undef VRD
  #undef KRD
  #undef STEP
  #undef ENDW
  {auto rr=__builtin_amdgcn_permlane32_swap(__float_as_uint(l_reg),__float_as_uint(l_reg),false,false);l_reg=__uint_as_float(rr[0])+__uint_as_float(rr[1]);}
  if(hi==0)wsf[32+r32]=l_reg;asm volatile("s_waitcnt lgkmcnt(0)":::"memory");
  float rli[16];
  #pragma unroll
  for(int r=0;r<16;++r)rli[r]=__builtin_amdgcn_rcpf(wsf[32+crow(r,hi)]);
  bf16*Ow=O+(rowbase+q0+wid*QBLK)*DM+h*D;
  { bf16*stg=(bf16*)(shm+LDS_OST)+wid*2048;
    #pragma unroll
    for(int r=0;r<16;++r){const int orow=crow(r,hi);
      #pragma unroll
      for(int d0=0;d0<2;++d0)stg[orow*64+d0*32+r32]=__float2bfloat16(o[d0][r]*rli[r]);}
    asm volatile("s_waitcnt lgkmcnt(0)":::"memory");
    #pragma unroll
    for(int i=0;i<4;++i){const int row=i*8+(lane>>3),ch=lane&7; const u32x4 v=*(const u32x4*)(stg+row*64+ch*8); ATTN_STORE16(Ow+(long)row*DM+ch*8,v);} }
  asm volatile("s_waitcnt lgkmcnt(0)\n\ts_barrier":::"memory");
  #undef DMA_K
  #undef DMA_V
  #undef KT
  #undef qrel
  #undef KEEPF
  #undef NEEDB
  #undef START
  #undef RESC
  #undef ROT
}
constexpr int ATTN_LDS_BYTES=LDS_BYTES;
#undef SBAR
#undef WAIT_BAR
}
#define GAS __attribute__((address_space(1)))
typedef GAS unsigned gu32;
#define RLX_AGENT __ATOMIC_RELAXED, __HIP_MEMORY_SCOPE_AGENT
#define XB_TMO      128
#define XB_XCNT(j)  (256  + 64 * (j))
#define XB_XSUB(j)  (1280 + 64 * (j))
#define XB_XGEN(j)  (2304 + 64 * (j))
#define XB_TOP      3328
#define XB_TOPGEN   3392
#define XCD_BAR_WORDS 3456
#define XB_SPIN_CAP (1u << 18)

__device__ __forceinline__ unsigned xb_ld(unsigned* p)              { return __hip_atomic_load(p, __ATOMIC_RELAXED, __HIP_MEMORY_SCOPE_AGENT); }
__device__ __forceinline__ unsigned xb_add(unsigned* p, unsigned v) { return __hip_atomic_fetch_add(p, v, __ATOMIC_RELAXED, __HIP_MEMORY_SCOPE_AGENT); }
__device__ __forceinline__ unsigned xb_xcc_id() { return (unsigned)__builtin_amdgcn_s_getreg((3 << 11) | 20) & 0xFu; }
#define XB_SPIN(cond, bar) do { unsigned _sp = 0; while (cond) { __builtin_amdgcn_s_sleep(1); \
    if ((++_sp & 255u) == 0u) { if (xb_ld(&(bar)[XB_TMO])) break; if (_sp > XB_SPIN_CAP) { atomicAdd(&(bar)[XB_TMO], 1u); break; } } } } while (0)

struct XcdBarrier {
    unsigned* bar; unsigned x;
    volatile LAS unsigned* st;
};

__device__ __forceinline__ XcdBarrier xcd_barrier_post(unsigned* bar, volatile LAS unsigned* st, const bool t0) {
    XcdBarrier b; b.bar = bar; b.x = xb_xcc_id(); b.st = st;
    if (t0) (void)xb_add(&bar[XB_XCNT(b.x)], 1u);
    return b;
}
__device__ __forceinline__ void xcd_barrier_complete(unsigned* bar, unsigned x, unsigned& nloc, unsigned& nx) {
    const unsigned G = gridDim.x * gridDim.y * gridDim.z;
    unsigned sum, cnt, mine, sp = 0u;
    for (;;) {
        sum = 0u; cnt = 0u; mine = 0u;
#pragma unroll
        for (unsigned j = 0; j < 16; ++j) { const unsigned c = xb_ld(&bar[XB_XCNT(j)]); sum += c; cnt += (c > 0u) ? 1u : 0u; mine = (j == x) ? c : mine; }
        if (sum == G) break;
        __builtin_amdgcn_s_sleep(1);
        if ((++sp & 255u) == 0u) { if (xb_ld(&bar[XB_TMO])) break; if (sp > XB_SPIN_CAP) { atomicAdd(&bar[XB_TMO], 1u); break; } }
    }
    nloc = mine > 0u ? mine : 1u; nx = cnt > 0u ? cnt : 1u;
}

__device__ __forceinline__ void xcd_barrier(const XcdBarrier& b, const bool t0) {
    asm volatile("s_waitcnt vmcnt(0)" ::: "memory");
    __syncthreads();
    if (t0) {
        unsigned* bar = b.bar;
        __builtin_amdgcn_s_waitcnt(0);
        unsigned nloc = b.st[0], nx = b.st[1];
        if (nloc == 0u) { xcd_barrier_complete(bar, b.x, nloc, nx); b.st[0] = nloc; b.st[1] = nx; }
        const unsigned old = xb_add(&bar[XB_XSUB(b.x)], 1u);
        const unsigned gen = old / nloc;
        if (old + 1u == (gen + 1u) * nloc) {
            __builtin_amdgcn_fence(__ATOMIC_RELEASE, "agent");
            asm volatile("s_waitcnt vmcnt(0)" ::: "memory");
            const unsigned og = xb_add(&bar[XB_TOP], 1u);
            const unsigned tg = og / nx;
            if (og + 1u == (tg + 1u) * nx) xb_add(&bar[XB_TOPGEN], 1u);
            else XB_SPIN(xb_ld(&bar[XB_TOPGEN]) == tg, bar);
            __builtin_amdgcn_fence(__ATOMIC_ACQUIRE, "agent");
            xb_add(&bar[XB_XGEN(b.x)], 1u);
            asm volatile("s_waitcnt vmcnt(0)" ::: "memory");
        } else {
            XB_SPIN(xb_ld(&bar[XB_XGEN(b.x)]) == gen, bar);
            __builtin_amdgcn_fence(__ATOMIC_ACQUIRE, "agent");
            asm volatile("s_waitcnt vmcnt(0)" ::: "memory");
        }
    }
    __syncthreads();
}
constexpr int NWAVES = 8;
constexpr int RING_OFF = 0, RING_BYTES = 131072;
constexpr int LDSCTL_OFF = RING_BYTES;
constexpr int LDS_BYTES = 147456;
constexpr int CW_BAR = 4096;
#ifndef PROBE_EXTRA
#define PROBE_EXTRA 0
#endif
#ifndef PROBE_KIND
#define PROBE_KIND K_ATTN
#endif
constexpr int N_PHASES = 17 + PROBE_EXTRA;
constexpr int CW_FIN = 16384;
enum { K_PROLOGUE = 0, K_POOL, K_POOLGEMM_UNUSED, K_UP, K_DOWN, K_QGEMM, K_ATTN, K_WO, K_FINAL };
#ifndef REP_KIND
#define REP_KIND -1
#endif
#ifndef REP_N
#define REP_N 2
#endif
constexpr size_t WS_DUMMY = 268 * MiB;
#ifndef NAIVE_ATTN
#define NAIVE_ATTN 0
#endif

struct Args { Params p; int ph_lo, ph_hi; };

__global__ void __launch_bounds__(NWAVES * 64, 2) mk_fwd(Args args) {
    extern __shared__ __attribute__((aligned(16))) unsigned char lds_raw[];
    asm volatile("s_nop 0\n\ts_nop 0\n\ts_nop 0\n\ts_nop 0\n\ts_nop 0\n\ts_nop 0\n\ts_nop 0" ::: "memory");
    LAS unsigned char* lds = (LAS unsigned char*)lds_raw;
    typedef const __attribute__((address_space(4))) Args* KArgs;
    const int tid0 = threadIdx.x, wave = __builtin_amdgcn_readfirstlane(tid0 >> 6);
    const int G = gridDim.x;
    unsigned char* ws0 = args.p.ws;
    volatile LAS unsigned* LCTL = (volatile LAS unsigned*)(lds + LDSCTL_OFF);
    for (int u = tid0; u < (LDS_BYTES - LDSCTL_OFF) / 4; u += NWAVES * 64) ((LAS unsigned*)(lds + LDSCTL_OFF))[u] = 0u;
    __syncthreads();
    const int lo = args.ph_lo, hi = args.ph_hi;
    const bool multi = (hi - lo) > 1;
    XcdBarrier bar; bar.bar = (unsigned*)(ws0 + WS_CTL) + CW_BAR; bar.x = 0; bar.st = nullptr;
    if (multi) bar = xcd_barrier_post((unsigned*)(ws0 + WS_CTL) + CW_BAR, LCTL + 8, tid0 == 0);
    const int gw = blockIdx.x * NWAVES + wave, NGW = G * NWAVES;

    static_assert(WS_V - WS_K == (size_t)M * D * 2, "V follows K");
    for (int ph = lo; ph < hi; ++ph) {
#define IS_T0 (wave == 0 && __builtin_amdgcn_mbcnt_hi(~0u, __builtin_amdgcn_mbcnt_lo(~0u, 0u)) == 0u)
#define PHASE_TID int lane = __builtin_amdgcn_mbcnt_hi(~0u, __builtin_amdgcn_mbcnt_lo(~0u, 0u)); asm volatile("" : "+v"(lane)); const int tid = wave * 64 + lane; (void)tid
        KArgs ka = (KArgs)__builtin_amdgcn_kernarg_segment_ptr(); asm volatile("" : "+s"(ka));
        size_t wsz = 0; asm volatile("" : "+s"(wsz)); unsigned char* ws = ka->p.ws + wsz;
        const int cb = (ph == 2 || ph == 3) ? 1 : 0;
        bf16_t* XB = (bf16_t*)(ws + (cb ? WS_K : WS_XB)); float* SS = (float*)(ws + (cb ? WS_SS2 : WS_SS)); bf16_t* ACT = (bf16_t*)(ws + WS_ACT);
        bf16_t* Kb = (bf16_t*)(ws + WS_K); bf16_t* Vb = (bf16_t*)(ws + WS_V); bf16_t* Qb = (bf16_t*)(ws + WS_Q); bf16_t* Ob = (bf16_t*)(ws + WS_O); bf16_t* Dp = (bf16_t*)(ws + WS_DP);
        float* KMP = (float*)(ws + WS_KMP); float* biasT = (float*)(ws + WS_BIAS);
        int kind, layer;
        if (ph == 0) { kind = K_PROLOGUE; layer = 0; }
        else if (PROBE_EXTRA > 0 && ph >= 17) { kind = PROBE_KIND; layer = 3; }
        else if (ph <= 6) { layer = (ph - 1) / 3; const int s = (ph - 1) % 3; kind = s == 0 ? K_POOL : (s == 1 ? K_UP : K_DOWN); }
        else { const int q = ph - 7; layer = 2 + q / 5; const int s = q % 5; kind = s == 0 ? K_QGEMM : (s == 1 ? K_ATTN : (s == 2 ? K_WO : (s == 3 ? K_UP : K_DOWN))); }

        const int reps = (REP_KIND >= 0 && kind == REP_KIND) ? REP_N : 1;
        for (int rep = 0; rep < reps; ++rep) {
        if (kind == K_PROLOGUE) { PHASE_TID;
            LAS float* scr = (LAS float*)(lds + RING_OFF + wave * 16384);
            Params p; p.x = ka->p.x; p.norm_mixer = ka->p.norm_mixer; p.norm_ffn = ka->p.norm_ffn; p.pool_w = ka->p.pool_w; p.pool_scale = ka->p.pool_scale; p.kv_norm = ka->p.kv_norm; p.w_kv = ka->p.w_kv; p.w_q = ka->p.w_q;
            p.w_o = ka->p.w_o; p.rel_bias = ka->p.rel_bias; p.w_gate_up = ka->p.w_gate_up; p.w_down = ka->p.w_down; p.final_norm = ka->p.final_norm; p.out = ka->p.out; p.ws = ws;
            for (int it = gw; it < IT_TOTAL; it += NGW) conv_dispatch(p, it, scr, lane);
            for (int r = gw; r < M; r += NGW) rowprep(p.x, XB, SS, r, lane);
            const int t = blockIdx.x * (NWAVES * 64) + tid;
            if (t < NH * 128) { const int h = t >> 7, d = t & 127; biasT[t] = (p.rel_bias[rel_bucket(d) * NH + h] - p.rel_bias[31 * NH + h]) * LOG2E; }
        } else if (kind == K_POOL) { PHASE_TID;
            const int ib = layer;
            const bf16_t* XBi = (const bf16_t*)(ws + (ib ? WS_K : WS_XB)); const float* SSi = (const float*)(ws + (ib ? WS_SS2 : WS_SS));
            pg8::EpiResid E; E.XB = XBi; E.XBo = (bf16_t*)(ws + (ib ? WS_XB : WS_K)); E.SS = (float*)(ws + (ib ? WS_SS : WS_SS2)); E.fout = nullptr; E.gfin = nullptr; E.slots = nullptr; E.cnt = nullptr; E.tid = tid;
            if (rep > 0) { E.XBo = (bf16_t*)(ws + WS_DUMMY); E.SS = (float*)(ws + WS_DUMMY); }
            pg8::StaticOrder S; S.init(M, D, G, (int)blockIdx.x);
            poolf::pool_phase(lds + RING_OFF, XBi, SSi, (const bf16_t*)(ws + WS_WPOOL) + (size_t)layer * 262144, S, E, tid);
        } else if (kind == K_WO || kind == K_DOWN) { PHASE_TID;
            pg8::Gemm g; pg8::EpiResid E; E.XB = XB; E.XBo = XB; E.SS = SS; g.N = D; g.a_pn_cols = 0; E.fout = nullptr; E.gfin = nullptr; E.slots = nullptr; E.cnt = nullptr; E.tid = tid;
            if (kind == K_DOWN && layer == 3 && rep == 0 && !(PROBE_EXTRA > 0 && ph >= 17)) { E.fout = ka->p.out; E.gfin = ka->p.final_norm; E.slots = (float*)(ws + WS_SS2); E.cnt = (unsigned*)(ws + WS_CTL) + CW_FIN; }
            if (kind == K_WO) { g.A = Ob; g.lda = D; g.Bt = (const bf16_t*)(ws + WS_WO) + (size_t)(layer - 2) * D * D; g.K = D; }
            else { g.A = ACT; g.lda = DFF; g.Bt = (const bf16_t*)(ws + WS_WDN) + (size_t)layer * WDN_STRIDE; g.K = DFF; }
            if (rep > 0 || (PROBE_EXTRA > 0 && ph >= 17)) { E.XBo = (bf16_t*)(ws + WS_DUMMY); E.SS = (float*)(ws + WS_DUMMY); }
            pg8::StaticOrder S; S.init(M, g.N, G, (int)blockIdx.x);
            pg8::gemm_phase<pg8::EpiResid, pg8::StaticOrder>(lds + RING_OFF, g, S, E, tid);
        } else if (kind == K_UP) { PHASE_TID;
            pg8::Gemm g; g.A = XB; g.lda = D; g.Bt = (const bf16_t*)(ws + WS_WGU) + (size_t)layer * WGU_STRIDE; g.K = D; g.N = NGU; g.a_pn_cols = 0;
            pg8::EpiSwiglu E; E.ACT = ACT; E.SS = SS; E.tid = tid; E.skip = 0;
#if defined(REP_VARIANT)
            if (rep > 0) { E.skip = 1; E.ACT = (bf16_t*)(ws + WS_DUMMY); }
#endif
            pg8::TailHalfOrder S; S.init(M, g.N, G, (int)blockIdx.x);
            pg8::gemm_phase<pg8::EpiSwiglu, pg8::TailHalfOrder>(lds + RING_OFF, g, S, E, tid);
        } else if (kind == K_QGEMM) { PHASE_TID;
            pg8::Gemm g; g.A = XB; g.lda = D; g.K = D; g.a_pn_cols = 0;
            pg8::EpiKVQ E; E.Kb = Kb; E.Qb = Qb; E.KMP = KMP; E.SS = SS; E.tid = tid;
            if (layer == 2) { g.Bt = (const bf16_t*)(ws + WS_WKVQ); g.N = 3 * D; E.pn_off = 0; } else { g.Bt = (const bf16_t*)(ws + WS_WQ1); g.N = D; E.pn_off = 8; }
            pg8::StaticOrder S; S.init(M, g.N, G, (int)blockIdx.x);
            pg8::gemm_phase<pg8::EpiKVQ, pg8::StaticOrder>(lds + RING_OFF, g, S, E, tid);
        } else if (kind == K_ATTN) { PHASE_TID;
#if NAIVE_ATTN
            const int hw = blockIdx.x * 2 + (tid >> 8), NHW = G * 2;
            for (int w = hw; w < BATCH * NH * 4; w += NHW) { const int bh = w >> 2, s = w & 3;
                attn_naive_unit(Qb, Kb, Vb, KMP, biasT, Ob, bh >> 4, bh & 15, s, tid & 255);
                attn_naive_unit(Qb, Kb, Vb, KMP, biasT, Ob, bh >> 4, bh & 15, 7 - s, tid & 255); }
#else
            const int bx = blockIdx.x, vcu = (G % 8 == 0) ? (bx % 8) * (G / 8) + bx / 8 : bx;
            for (int u2 = 2 * vcu; u2 < BATCH * NH * 8; u2 += (u2 & 1) ? 2 * G - 1 : 1) { const int pp = u2 >> 1, bh = pp >> 2, s = pp & 3, own = (u2 & 1) ? 7 - s : s;
#if defined(REP_VARIANT)
                if (rep > 0) attn_body::attn_unit<8, true>(bh >> 4, bh & 15, own, (const attn_body::bf16*)Qb, (const attn_body::bf16*)Kb, (const attn_body::bf16*)Vb, (attn_body::bf16*)(ws + WS_DUMMY), KMP, biasT, (char*)lds_raw + RING_OFF, wave); else
#endif
                attn_body::attn_unit<8>(bh >> 4, bh & 15, own, (const attn_body::bf16*)Qb, (const attn_body::bf16*)Kb, (const attn_body::bf16*)Vb, (attn_body::bf16*)Ob, KMP, biasT, (char*)lds_raw + RING_OFF, wave); }
#endif
        }
        if (rep + 1 < reps) xcd_barrier(bar, IS_T0);
        }
        if (multi && ph + 1 < hi) { xcd_barrier(bar, IS_T0); if (REP_KIND == 100) xcd_barrier(bar, IS_T0); }
    }
}

extern "C" void kernel_launch(void* const* d_in, const int* in_sizes, int n_in, void* d_out, int out_size, void* d_ws, size_t ws_size, hipStream_t stream) {
    static int grid = 0;
    if (grid == 0) {
        if (n_in != 13 || in_sizes[0] != M * D || out_size != M * D || ws_size < ((REP_KIND >= 0 || PROBE_EXTRA > 0) ? WS_DUMMY + 64 * MiB : WS_END)) {
            fprintf(stderr, "kernel_launch: unexpected shapes (n_in %d, in0 %d, out %d, ws %zu); nothing launched\n", n_in, n_in > 0 ? in_sizes[0] : -1, out_size, ws_size); grid = -1; return; }
        int dev = 0, cus = 0, per_cu = 0;
        if (hipGetDevice(&dev) != hipSuccess || hipDeviceGetAttribute(&cus, hipDeviceAttributeMultiprocessorCount, dev) != hipSuccess) { fprintf(stderr, "kernel_launch: device query failed\n"); grid = -1; return; }
        if (hipFuncSetAttribute((const void*)mk_fwd, hipFuncAttributeMaxDynamicSharedMemorySize, LDS_BYTES) != hipSuccess) { fprintf(stderr, "kernel_launch: hipFuncSetAttribute failed\n"); grid = -1; return; }
        if (hipOccupancyMaxActiveBlocksPerMultiprocessor(&per_cu, (const void*)mk_fwd, NWAVES * 64, LDS_BYTES) != hipSuccess || per_cu < 1) {
            fprintf(stderr, "kernel_launch: occupancy query reports %d workgroups per CU; nothing launched\n", per_cu); (void)hipGetLastError(); grid = -1; return; }
        if (cus < 256) { fprintf(stderr, "kernel_launch: %d CUs; this kernel's unit tables are sized for 256 workgroups; nothing launched\n", cus); grid = -1; return; }
        grid = 256;
    }
    if (grid < 0) return;
    if (hipMemsetAsync((char*)d_ws + WS_CTL, 0, 1 * MiB, stream) != hipSuccess) { fprintf(stderr, "kernel_launch: hipMemsetAsync failed\n"); return; }
    Args a{};
    a.p.x = (const float*)d_in[0]; a.p.norm_mixer = (const float*)d_in[1]; a.p.norm_ffn = (const float*)d_in[2]; a.p.pool_w = (const float*)d_in[3]; a.p.pool_scale = (const float*)d_in[4];
    a.p.kv_norm = (const float*)d_in[5]; a.p.w_kv = (const float*)d_in[6]; a.p.w_q = (const float*)d_in[7]; a.p.w_o = (const float*)d_in[8]; a.p.rel_bias = (const float*)d_in[9];
    a.p.w_gate_up = (const float*)d_in[10]; a.p.w_down = (const float*)d_in[11]; a.p.final_norm = (const float*)d_in[12];
    a.p.out = (float*)d_out; a.p.ws = (unsigned char*)d_ws;
    a.ph_lo = 0; a.ph_hi = N_PHASES;
    hipLaunchKernelGGL(mk_fwd, dim3(grid), dim3(NWAVES * 64), LDS_BYTES, stream, a);
    const hipError_t le = hipPeekAtLastError();
    if (le != hipSuccess) fprintf(stderr, "kernel_launch: launch failed: %s\n", hipGetErrorName(le));
}
```

```cpp
#include <hip/hip_runtime.h>
#include <cstdio>
#include <cstdint>

#define LAS __attribute__((address_space(3)))
typedef unsigned short bf16_t;
typedef short bf16x8 __attribute__((ext_vector_type(8)));
typedef float f32x4 __attribute__((ext_vector_type(4)));
typedef unsigned u32x4 __attribute__((ext_vector_type(4)));
typedef unsigned u32x2 __attribute__((ext_vector_type(2)));
typedef float f32x2_t __attribute__((ext_vector_type(2)));
typedef __bf16 bf16x2_t __attribute__((ext_vector_type(2)));

constexpr int BATCH = 8, SEQ = 2048, D = 1024, M = BATCH * SEQ, DFF = 2816, NGU = 2 * DFF, NH = 16, HD = 64, NBLK = SEQ / 256;
constexpr float EPS = 1e-6f;
constexpr float QSCALE = 0.125f * 1.4426950408889634f;
constexpr float LOG2E = 1.4426950408889634f;

constexpr size_t MiB = 1u << 20;
constexpr size_t WS_CTL = 0;
constexpr size_t WS_KMP = 1 * MiB;
constexpr size_t WS_SS = 2 * MiB;
constexpr size_t WS_BIAS = 3 * MiB;
constexpr size_t WS_WPOOL = 4 * MiB;
constexpr size_t WS_WKVQ = 5 * MiB;
constexpr size_t WS_WQ1 = 11 * MiB;
constexpr size_t WS_WO = 13 * MiB;
constexpr size_t WS_WGU = 17 * MiB;
constexpr size_t WS_WDN = 61 * MiB;
constexpr size_t WS_SS2 = 83 * MiB;
constexpr size_t WS_XB = 84 * MiB;
constexpr size_t WS_K = 116 * MiB;
constexpr size_t WS_V = 148 * MiB;
constexpr size_t WS_ACT = 180 * MiB;
constexpr size_t WS_Q = WS_ACT, WS_O = WS_ACT + 32 * MiB, WS_DP = WS_ACT;
constexpr size_t WS_END = 268 * MiB;
constexpr size_t WGU_STRIDE = (size_t)NGU * D, WDN_STRIDE = (size_t)D * DFF;

__device__ __forceinline__ unsigned cvtpk(float lo, float hi) { f32x2_t v = {lo, hi}; bf16x2_t b = __builtin_convertvector(v, bf16x2_t); return __builtin_bit_cast(unsigned, b); }
__device__ __forceinline__ void st16_wt(void* p, u32x4 v) { asm volatile("global_store_dwordx4 %0, %1, off sc1\n\ts_nop 1" :: "v"(p), "v"(v) : "memory"); }
__device__ __forceinline__ float bf_lo(unsigned w) { return __uint_as_float(w << 16); }
__device__ __forceinline__ float bf_hi(unsigned w) { return __uint_as_float(w & 0xffff0000u); }
template <int CTRL> __device__ __forceinline__ float dpp_f(float v) { return __uint_as_float((unsigned)__builtin_amdgcn_update_dpp(0, (int)__float_as_uint(v), CTRL, 0xf, 0xf, false)); }
__device__ __forceinline__ float row16_sum(float v) { v += dpp_f<0x128>(v); v += dpp_f<0x124>(v); v += dpp_f<0x122>(v); v += dpp_f<0x121>(v); return v; }
__device__ __forceinline__ float xor16_sum(float v) { auto r = __builtin_amdgcn_permlane16_swap(__float_as_uint(v), __float_as_uint(v), false, false); return __uint_as_float(r[0]) + __uint_as_float(r[1]); }
__device__ __forceinline__ float xor32_sum(float v) { auto r = __builtin_amdgcn_permlane32_swap(__float_as_uint(v), __float_as_uint(v), false, false); return __uint_as_float(r[0]) + __uint_as_float(r[1]); }
__device__ __forceinline__ float wave_sum(float v) { return xor32_sum(xor16_sum(row16_sum(v))); }
__device__ __forceinline__ float lane_bcast(float v, int l) { return __uint_as_float((unsigned)__builtin_amdgcn_readlane((int)__float_as_uint(v), l)); }
__device__ __forceinline__ float row_rstd(const float* SS, int row) {
    const f32x4* p = (const f32x4*)(SS + (size_t)row * 16);
    const f32x4 a = p[0], b = p[1], c = p[2], d = p[3];
    const float s = (((a.x + a.y) + (a.z + a.w)) + ((b.x + b.y) + (b.z + b.w))) + (((c.x + c.y) + (c.z + c.w)) + ((d.x + d.y) + (d.z + d.w)));
    return 1.0f / sqrtf(s * (1.0f / D) + EPS);
}
__device__ __forceinline__ int rel_bucket(int n) {
    if (n < 16) return n;
    int b = 16;
    b += (n >= 19); b += (n >= 21); b += (n >= 24); b += (n >= 27); b += (n >= 31); b += (n >= 35); b += (n >= 40); b += (n >= 46);
    b += (n >= 52); b += (n >= 59); b += (n >= 67); b += (n >= 77); b += (n >= 87); b += (n >= 99); b += (n >= 113);
    return b;
}

struct Params {
    const float* x; const float* norm_mixer; const float* norm_ffn; const float* pool_w; const float* pool_scale; const float* kv_norm;
    const float* w_kv; const float* w_q; const float* w_o; const float* rel_bias; const float* w_gate_up; const float* w_down; const float* final_norm;
    float* out; unsigned char* ws;
};

__device__ __forceinline__ void conv_item(const float* W, int ldw, int k0, int ns0, bf16_t* WT, int ldt, int nd0, const float* gk, const float* gn, float cs, LAS float* scr, int lane) {
    const int c4 = (lane & 7) * 4, kr = lane >> 3;
    f32x4 sn = (f32x4){cs, cs, cs, cs}; if (gn) sn = sn * *(const f32x4*)(gn + ns0 + c4);
    f32x4 w[8];
#pragma unroll
    for (int i = 0; i < 8; ++i) w[i] = __builtin_nontemporal_load((const f32x4*)(W + (size_t)(k0 + 8 * i + kr) * ldw + ns0 + c4));
#pragma unroll
    for (int i = 0; i < 8; ++i) { const int kk = 8 * i + kr; f32x4 v = w[i] * sn; if (gk) v = v * gk[k0 + kk];
        LAS float* d = scr + kk * 33 + c4; d[0] = v.x; d[1] = v.y; d[2] = v.z; d[3] = v.w; }
    asm volatile("s_waitcnt lgkmcnt(0)" ::: "memory");
    const int ch = lane & 7;
#pragma unroll
    for (int j = 0; j < 4; ++j) { const int n = (lane >> 3) + 8 * j; const LAS float* s = scr + (8 * ch) * 33 + n;
        u32x4 o; o.x = cvtpk(s[0 * 33], s[1 * 33]); o.y = cvtpk(s[2 * 33], s[3 * 33]); o.z = cvtpk(s[4 * 33], s[5 * 33]); o.w = cvtpk(s[6 * 33], s[7 * 33]);
        *(u32x4*)(WT + (size_t)(nd0 + n) * ldt + k0 + 8 * ch) = o; }
    asm volatile("s_waitcnt lgkmcnt(0)" ::: "memory");
}
constexpr int IT_POOL = 8 * 32, IT_KV = 16 * 64, IT_Q = 16 * 32, IT_O = 16 * 32, IT_GU = 16 * 176, IT_DN = 44 * 32;
constexpr int IT_TOTAL = IT_POOL + IT_KV + 2 * IT_Q + 2 * IT_O + 4 * IT_GU + 4 * IT_DN;
__device__ __forceinline__ void conv_dispatch(const Params& p, int it, LAS float* scr, int lane) {
    unsigned char* ws = p.ws;
    int r = it;
    if (r < IT_POOL) { const int lg = r >> 5, l = lg >> 2, g = lg & 3, q = r & 31, kb = q >> 3, nb = q & 7;
        conv_item(p.pool_w + (size_t)lg * 65536, 256, 64 * kb, 32 * nb, (bf16_t*)(ws + WS_WPOOL) + (size_t)l * 262144, 256, 256 * g + 32 * nb,
                  p.norm_mixer + l * D + 256 * g, p.pool_scale + l * D + 256 * g, 1.f, scr, lane); return; } r -= IT_POOL;
    if (r < IT_KV) { const int kb = r >> 6, nb = r & 63;
        conv_item(p.w_kv, 2048, 64 * kb, 32 * nb, (bf16_t*)(ws + WS_WKVQ), D, 32 * nb, p.kv_norm, nullptr, 1.f, scr, lane); return; } r -= IT_KV;
    if (r < 2 * IT_Q) { const int j = r / IT_Q, q = r % IT_Q, kb = q >> 5, nb = q & 31;
        bf16_t* dst = j == 0 ? (bf16_t*)(ws + WS_WKVQ) + (size_t)2048 * D : (bf16_t*)(ws + WS_WQ1);
        conv_item(p.w_q + (size_t)j * D * D, D, 64 * kb, 32 * nb, dst, D, 32 * nb, p.norm_mixer + (2 + j) * D, nullptr, QSCALE, scr, lane); return; } r -= 2 * IT_Q;
    if (r < 2 * IT_O) { const int j = r / IT_O, q = r % IT_O, kb = q >> 5, nb = q & 31;
        conv_item(p.w_o + (size_t)j * D * D, D, 64 * kb, 32 * nb, (bf16_t*)(ws + WS_WO) + (size_t)j * D * D, D, 32 * nb, nullptr, nullptr, 1.f, scr, lane); return; } r -= 2 * IT_O;
    if (r < 4 * IT_GU) { const int l = r / IT_GU, q = r % IT_GU, kb = q / 176, nb = q % 176;
        const int nd0 = 32 * nb, pn = nd0 >> 8, bj = (nd0 >> 7) & 1, i = nd0 & 127, ns0 = bj * DFF + 128 * pn + i;
        conv_item(p.w_gate_up + (size_t)l * D * NGU, NGU, 64 * kb, ns0, (bf16_t*)(ws + WS_WGU) + (size_t)l * WGU_STRIDE, D, nd0, p.norm_ffn + l * D, nullptr, 1.f, scr, lane); return; } r -= 4 * IT_GU;
    { const int l = r / IT_DN, q = r % IT_DN, kb = q >> 5, nb = q & 31;
        conv_item(p.w_down + (size_t)l * DFF * D, D, 64 * kb, 32 * nb, (bf16_t*)(ws + WS_WDN) + (size_t)l * WDN_STRIDE, DFF, 32 * nb, nullptr, nullptr, 1.f, scr, lane); }
}

__device__ __forceinline__ void rowprep(const float* x, bf16_t* XB, float* SS, int row, int lane) {
    const f32x4* xr = (const f32x4*)(x + (size_t)row * D) + lane;
    f32x4 v[4]; float s = 0.f; u32x2 w[4];
#pragma unroll
    for (int j = 0; j < 4; ++j) v[j] = __builtin_nontemporal_load(xr + 64 * j);
#pragma unroll
    for (int j = 0; j < 4; ++j) { w[j].x = cvtpk(v[j].x, v[j].y); w[j].y = cvtpk(v[j].z, v[j].w);
        const float a = bf_lo(w[j].x), b = bf_hi(w[j].x), c = bf_lo(w[j].y), d = bf_hi(w[j].y); s += (a * a + b * b) + (c * c + d * d); }
    s = wave_sum(s);
    u32x2* o = (u32x2*)(XB + (size_t)row * D) + lane;
#pragma unroll
    for (int j = 0; j < 4; ++j) o[64 * j] = w[j];
    if (lane < 16) SS[(size_t)row * 16 + lane] = lane == 0 ? s : 0.f;
}

__device__ __forceinline__ void final_row(const bf16_t* XB, float* out, const float* SS, const float* g, int row, int lane) {
    const float r = row_rstd(SS, row);
    const u32x2* xr = (const u32x2*)(XB + (size_t)row * D) + lane; f32x4* orow = (f32x4*)(out + (size_t)row * D) + lane; const f32x4* gr = (const f32x4*)g + lane;
#pragma unroll
    for (int j = 0; j < 4; ++j) { const u32x2 w = xr[64 * j]; const f32x4 gg = gr[64 * j]; const f32x4 v = (f32x4){bf_lo(w.x), bf_hi(w.x), bf_lo(w.y), bf_hi(w.y)}; orow[64 * j] = v * r * gg; }
}

struct Epi {
    const float* base; float* XF; bf16_t* XB; float* SS; bf16_t* ACT; bf16_t* Kb; bf16_t* Vb; bf16_t* Qb; float* KMP;
};
__device__ __forceinline__ float silu_mul(float g, float u) { return g * __builtin_amdgcn_rcpf(1.0f + __builtin_amdgcn_exp2f(g * -LOG2E)) * u; }

namespace pg8 {
#define PG8_LAS __attribute__((address_space(3)))
constexpr int BM = 256, BK = 64, HALF = 128, HTB = HALF * BK * 2  , STAGE_BYTES = 8 * HTB, NXCD = 8, WGM = 8;

#ifndef PG8_OLD_IMAGE
__host__ __device__ __forceinline__ int lds_byte(int r, int c) { return (r >> 3) * 1024 + (r & 7) * 128 + (((c >> 3) ^ ((r >> 1) & 7)) << 4) + (c & 7) * 2; }
__host__ __device__ __forceinline__ void stage_rc(int b, int& R, int& C) { const int st = b >> 10, sb = b & 1023, row = sb >> 7, chs = (sb >> 4) & 7; R = st * 8 + row; C = ((chs ^ ((R >> 1) & 7)) << 3) + ((sb & 15) >> 1); }
#else
__host__ __device__ __forceinline__ int lds_byte(int r, int c) { const int st = (r >> 4) * 2 + (c >> 5), rr = r & 15, cc = c & 31, ob = rr * 64 + cc * 2; return st * 1024 + (ob ^ (((ob >> 9) & 1) << 5)); }
__host__ __device__ __forceinline__ void stage_rc(int b, int& R, int& C) { const int st = b / 1024, sb = b % 1024, swz = sb ^ (((sb >> 9) & 1) << 5); R = (st >> 1) * 16 + swz / 64; C = (st & 1) * 32 + (swz % 64) / 2; }
#endif
__host__ __device__ __forceinline__ int perm32(int rho) { const int n = rho >> 4, i = rho & 15; return 8 * (i >> 2) + 4 * n + (i & 3); }

struct Unit { int pm, pn, hm; };
struct Gemm { const bf16_t* A; const bf16_t* Bt; int lda; int K; int N; int a_pn_cols; };

struct StaticOrder {
    int nM, nN, nwg, G, c;
    __device__ void init(int M_, int N_, int G_, int c_) { nM = M_ / BM; nN = N_ / BM; nwg = nM * nN; G = G_; c = c_; }
    __device__ bool next(int i, Unit& u) const {
        const long L = (long)i * G + c; if (L >= nwg) return false;
        int wgid = (int)L; { const int q = nwg / NXCD, r = nwg % NXCD, xcd = wgid % NXCD, off = wgid / NXCD; wgid = (xcd < r ? xcd * (q + 1) : r * (q + 1) + (xcd - r) * q) + off; }
        const int nig = WGM * nN, gid = wgid / nig, fm = gid * WGM, gsz = (nM - fm) < WGM ? (nM - fm) : WGM;
        u.pm = fm + ((wgid % nig) % gsz); u.pn = (wgid % nig) / gsz; u.hm = -1; return true;
    }
};
struct TailHalfOrder : StaticOrder {
    __device__ bool next(int i, Unit& u) const {
        const int full = nwg / G;
        if (i < full || 2 * (nwg % G) != G) return StaticOrder::next(i, u);
        if (i > full) return false;
        const int xcd = c % NXCD, k = c / NXCD, off = full * (G / NXCD) + (k >> 1);
        const int q = nwg / NXCD; int wgid = xcd * q + off;
        const int nig = WGM * nN, gid = wgid / nig, fm = gid * WGM, gsz = (nM - fm) < WGM ? (nM - fm) : WGM;
        u.pm = fm + ((wgid % nig) % gsz); u.pn = (wgid % nig) / gsz; u.hm = k & 1; return true;
    }
};

struct EpiResid {
    static constexpr bool PERM = true;
    const bf16_t* XB; bf16_t* XBo; float* SS;
    float* fout; const float* gfin; float* slots; unsigned* cnt; int tid;
    __device__ __forceinline__ void operator()(const f32x4 (&acc)[2][2][4][2], const Unit& u, int wr, int wc, int fr, int fq) const {
        if (fout) { final_fused(acc, u, wr, wc, fr, fq); return; }
#pragma unroll
        for (int ai = 0; ai < 2; ++ai) rows(acc[ai], u, ai, wr, wc, fr, fq);
    }
    __device__ __forceinline__ void final_fused(const f32x4 (&acc)[2][2][4][2], const Unit& u, int wr, int wc, int fr, int fq) const {
        const int col0 = u.pn * BM + wc * 32 + 8 * fq;
        PG8_LAS float* P = (PG8_LAS float*)(131072 + 8192);
        PG8_LAS float* R = (PG8_LAS float*)(131072 + 8192 + 4096);
#pragma unroll
        for (int ai = 0; ai < 2; ++ai)
#pragma unroll
            for (int m = 0; m < 4; ++m) { const int rl = ai * HALF + wr * 64 + m * 16 + fr; const size_t off = (size_t)(u.pm * BM + rl) * D + col0; float ssq = 0.f;
#pragma unroll
                for (int bj = 0; bj < 2; ++bj) { const u32x4 b = *(const u32x4*)(XB + off + bj * HALF); const f32x4 a0 = acc[ai][bj][m][0], a1 = acc[ai][bj][m][1];
                    const float v0 = bf_lo(b.x) + a0.x, v1 = bf_hi(b.x) + a0.y, v2 = bf_lo(b.y) + a0.z, v3 = bf_hi(b.y) + a0.w, v4 = bf_lo(b.z) + a1.x, v5 = bf_hi(b.z) + a1.y, v6 = bf_lo(b.w) + a1.z, v7 = bf_hi(b.w) + a1.w;
                    ssq += ((v0 * v0 + v1 * v1) + (v2 * v2 + v3 * v3)) + ((v4 * v4 + v5 * v5) + (v6 * v6 + v7 * v7)); }
                ssq = xor32_sum(xor16_sum(ssq));
                if (fq == 0) P[rl * 4 + wc] = ssq; }
        asm volatile("s_waitcnt lgkmcnt(0)" ::: "memory"); __builtin_amdgcn_s_barrier(); asm volatile("" ::: "memory");
        if (tid < 256) { const float s = (P[tid * 4] + P[tid * 4 + 1]) + (P[tid * 4 + 2] + P[tid * 4 + 3]);
            __hip_atomic_store(slots + (size_t)(u.pm * BM + tid) * 4 + u.pn, s, __ATOMIC_RELAXED, __HIP_MEMORY_SCOPE_AGENT); }
        asm volatile("s_waitcnt vmcnt(0)" ::: "memory"); __builtin_amdgcn_s_barrier(); asm volatile("" ::: "memory");
        if (tid == 0) __hip_atomic_fetch_add(cnt + 64 * u.pm, 1u, __ATOMIC_RELAXED, __HIP_MEMORY_SCOPE_AGENT);
        if (tid < 64) { unsigned spins = 0;
            while ((unsigned)__builtin_amdgcn_readfirstlane((int)__hip_atomic_load(cnt + 64 * u.pm, __ATOMIC_RELAXED, __HIP_MEMORY_SCOPE_AGENT)) < 4u) { __builtin_amdgcn_s_sleep(2); if (++spins > (1u << 22)) break; } }
        asm volatile("s_waitcnt vmcnt(0) lgkmcnt(0)" ::: "memory"); __builtin_amdgcn_s_barrier(); asm volatile("" ::: "memory");
        if (tid < 256) { const float* sl = slots + (size_t)(u.pm * BM + tid) * 4; float s = 0.f;
#pragma unroll
            for (int t = 0; t < 4; ++t) s += __hip_atomic_load(sl + t, __ATOMIC_RELAXED, __HIP_MEMORY_SCOPE_AGENT);
            R[tid] = 1.0f / sqrtf(s * (1.0f / D) + EPS); }
        asm volatile("s_waitcnt vmcnt(0) lgkmcnt(0)" ::: "memory"); __builtin_amdgcn_s_barrier(); asm volatile("" ::: "memory");
        f32x4 g4[2][2];
#pragma unroll
        for (int bj = 0; bj < 2; ++bj) { g4[bj][0] = *(const f32x4*)(gfin + col0 + bj * HALF); g4[bj][1] = *(const f32x4*)(gfin + col0 + bj * HALF + 4); }
#pragma unroll
        for (int ai = 0; ai < 2; ++ai)
#pragma unroll
            for (int m = 0; m < 4; ++m) { const int rl = ai * HALF + wr * 64 + m * 16 + fr; const size_t off = (size_t)(u.pm * BM + rl) * D + col0; const float rs = R[rl];
#pragma unroll
                for (int bj = 0; bj < 2; ++bj) { const u32x4 b = *(const u32x4*)(XB + off + bj * HALF); const f32x4 a0 = acc[ai][bj][m][0], a1 = acc[ai][bj][m][1];
                    f32x4 o0, o1; o0.x = (bf_lo(b.x) + a0.x) * rs; o0.y = (bf_hi(b.x) + a0.y) * rs; o0.z = (bf_lo(b.y) + a0.z) * rs; o0.w = (bf_hi(b.y) + a0.w) * rs;
                    o1.x = (bf_lo(b.z) + a1.x) * rs; o1.y = (bf_hi(b.z) + a1.y) * rs; o1.z = (bf_lo(b.w) + a1.z) * rs; o1.w = (bf_hi(b.w) + a1.w) * rs;
                    __builtin_nontemporal_store(o0 * g4[bj][0], (f32x4*)(fout + off + bj * HALF)); __builtin_nontemporal_store(o1 * g4[bj][1], (f32x4*)(fout + off + bj * HALF + 4)); } }
    }
    __device__ __forceinline__ void rows_load(u32x4 (&xb)[4][2], const Unit& u, int ai, int wr, int wc, int fr, int fq) const {
        const int col0 = u.pn * BM + wc * 32 + 8 * fq;
#pragma unroll
        for (int m = 0; m < 4; ++m)
#pragma unroll
            for (int bj = 0; bj < 2; ++bj) xb[m][bj] = *(const u32x4*)(XB + (size_t)(u.pm * BM + ai * HALF + wr * 64 + m * 16 + fr) * D + col0 + bj * HALF);
    }
    __device__ __forceinline__ void rows_finish(const f32x4 (&a)[2][4][2], const u32x4 (&xb)[4][2], const Unit& u, int ai, int wr, int wc, int fr, int fq) const {
        const int col0 = u.pn * BM + wc * 32 + 8 * fq;
#pragma unroll
        for (int m = 0; m < 4; ++m) { const int row = u.pm * BM + ai * HALF + wr * 64 + m * 16 + fr; const size_t off = (size_t)row * D + col0; float ssq = 0.f;
#pragma unroll
            for (int bj = 0; bj < 2; ++bj) { const u32x4 b = xb[m][bj]; const f32x4 a0 = a[bj][m][0], a1 = a[bj][m][1];
                u32x4 w; w.x = cvtpk(bf_lo(b.x) + a0.x, bf_hi(b.x) + a0.y); w.y = cvtpk(bf_lo(b.y) + a0.z, bf_hi(b.y) + a0.w);
                w.z = cvtpk(bf_lo(b.z) + a1.x, bf_hi(b.z) + a1.y); w.w = cvtpk(bf_lo(b.w) + a1.z, bf_hi(b.w) + a1.w);
                *(u32x4*)(XBo + off + bj * HALF) = w;
                const float r0 = bf_lo(w.x), r1 = bf_hi(w.x), r2 = bf_lo(w.y), r3 = bf_hi(w.y), r4 = bf_lo(w.z), r5 = bf_hi(w.z), r6 = bf_lo(w.w), r7 = bf_hi(w.w);
                ssq += ((r0 * r0 + r1 * r1) + (r2 * r2 + r3 * r3)) + ((r4 * r4 + r5 * r5) + (r6 * r6 + r7 * r7)); }
            ssq = xor32_sum(xor16_sum(ssq));
            if (fq == 0) SS[(size_t)row * 16 + u.pn * 4 + wc] = ssq; }
    }
    __device__ __forceinline__ void rows(const f32x4 (&a)[2][4][2], const Unit& u, int ai, int wr, int wc, int fr, int fq) const {
        const int col0 = u.pn * BM + wc * 32 + 8 * fq;
        {
#ifdef EPI_BATCH
            u32x4 xb[4][2];
#pragma unroll
            for (int m = 0; m < 4; ++m)
#pragma unroll
                for (int bj = 0; bj < 2; ++bj) xb[m][bj] = *(const u32x4*)(XB + (size_t)(u.pm * BM + ai * HALF + wr * 64 + m * 16 + fr) * D + col0 + bj * HALF);
            __builtin_amdgcn_sched_barrier(0);
#endif
#pragma unroll
            for (int m = 0; m < 4; ++m) { const int row = u.pm * BM + ai * HALF + wr * 64 + m * 16 + fr; const size_t off = (size_t)row * D + col0; float ssq = 0.f;
#pragma unroll
                for (int bj = 0; bj < 2; ++bj) {
#ifdef EPI_BATCH
                    const u32x4 b = xb[m][bj];
#else
                    const u32x4 b = *(const u32x4*)(XB + off + bj * HALF);
#endif
                    const f32x4 a0 = a[bj][m][0], a1 = a[bj][m][1];
                    u32x4 w; w.x = cvtpk(bf_lo(b.x) + a0.x, bf_hi(b.x) + a0.y); w.y = cvtpk(bf_lo(b.y) + a0.z, bf_hi(b.y) + a0.w);
                    w.z = cvtpk(bf_lo(b.z) + a1.x, bf_hi(b.z) + a1.y); w.w = cvtpk(bf_lo(b.w) + a1.z, bf_hi(b.w) + a1.w);
                    *(u32x4*)(XBo + off + bj * HALF) = w;
                    const float r0 = bf_lo(w.x), r1 = bf_hi(w.x), r2 = bf_lo(w.y), r3 = bf_hi(w.y), r4 = bf_lo(w.z), r5 = bf_hi(w.z), r6 = bf_lo(w.w), r7 = bf_hi(w.w);
                    ssq += ((r0 * r0 + r1 * r1) + (r2 * r2 + r3 * r3)) + ((r4 * r4 + r5 * r5) + (r6 * r6 + r7 * r7)); }
                ssq = xor32_sum(xor16_sum(ssq));
                if (fq == 0) SS[(size_t)row * 16 + u.pn * 4 + wc] = ssq; }
        }
    }
};
constexpr int RSTD_TAB_OFF = 131072 + 4096, RSTD_TAG_OFF = RSTD_TAB_OFF + 1024;
__device__ __forceinline__ const PG8_LAS float* rstd_table(const float* SS, int pm, int tid) {
    PG8_LAS float* tab = (PG8_LAS float*)(RSTD_TAB_OFF); volatile PG8_LAS int* tag = (volatile PG8_LAS int*)(RSTD_TAG_OFF);
    if (*tag == pm) return tab;
    if (tid < 256) tab[tid] = row_rstd(SS, pm * BM + tid);
    asm volatile("s_waitcnt lgkmcnt(0)" ::: "memory"); __builtin_amdgcn_s_barrier(); asm volatile("" ::: "memory");
    if (tid == 0) *tag = pm;
    return tab;
}
__device__ __forceinline__ void rstd_table_reset(int tid) { if (tid == 0) *(volatile PG8_LAS int*)(RSTD_TAG_OFF) = -1; }
struct EpiSwiglu {
    static constexpr bool PERM = true;
    bf16_t* ACT; const float* SS; int tid; int skip;
    __device__ __forceinline__ void operator()(const f32x4 (&acc)[2][2][4][2], const Unit& u, int wr, int wc, int fr, int fq) const {
        if (skip && SS[0] != 123456.75f) return;
        const int col0 = u.pn * HALF + wc * 32 + 8 * fq;
        const PG8_LAS float* tab = rstd_table(SS, u.pm, tid);
        const int nai = u.hm < 0 ? 2 : 1, rb = u.hm < 0 ? 0 : u.hm * HALF;
#pragma unroll
        for (int ai = 0; ai < 2; ++ai) if (ai < nai)
#pragma unroll
            for (int m = 0; m < 4; ++m) { const int rl = rb + ai * HALF + wr * 64 + m * 16 + fr, row = u.pm * BM + rl; const float rs = tab[rl];
                const f32x4 g0 = acc[ai][0][m][0] * rs, g1 = acc[ai][0][m][1] * rs, u0 = acc[ai][1][m][0] * rs, u1 = acc[ai][1][m][1] * rs;
                const f32x4 x0 = g0 * -LOG2E, x1 = g1 * -LOG2E;
                f32x4 e0, e1; e0.x = __builtin_amdgcn_exp2f(x0.x); e0.y = __builtin_amdgcn_exp2f(x0.y); e0.z = __builtin_amdgcn_exp2f(x0.z); e0.w = __builtin_amdgcn_exp2f(x0.w);
                e1.x = __builtin_amdgcn_exp2f(x1.x); e1.y = __builtin_amdgcn_exp2f(x1.y); e1.z = __builtin_amdgcn_exp2f(x1.z); e1.w = __builtin_amdgcn_exp2f(x1.w);
                const f32x4 d0 = e0 + 1.0f, d1 = e1 + 1.0f;
                f32x4 r0, r1; r0.x = __builtin_amdgcn_rcpf(d0.x); r0.y = __builtin_amdgcn_rcpf(d0.y); r0.z = __builtin_amdgcn_rcpf(d0.z); r0.w = __builtin_amdgcn_rcpf(d0.w);
                r1.x = __builtin_amdgcn_rcpf(d1.x); r1.y = __builtin_amdgcn_rcpf(d1.y); r1.z = __builtin_amdgcn_rcpf(d1.z); r1.w = __builtin_amdgcn_rcpf(d1.w);
                const f32x4 o0 = (g0 * u0) * r0, o1 = (g1 * u1) * r1;
                u32x4 w; w.x = cvtpk(o0.x, o0.y); w.y = cvtpk(o0.z, o0.w); w.z = cvtpk(o1.x, o1.y); w.w = cvtpk(o1.z, o1.w);
                st16_wt(ACT + (size_t)row * DFF + col0, w); }
    }
};
struct EpiKVQ {
    static constexpr bool PERM = true;
    bf16_t* Kb; bf16_t* Qb; float* KMP; const float* SS; int pn_off; int tid;
    __device__ __forceinline__ void operator()(const f32x4 (&acc)[2][2][4][2], const Unit& u, int wr, int wc, int fr, int fq) const {
        const int tile = u.pn + pn_off, t = tile >> 2, col0 = (tile & 3) * BM + wc * 32 + 8 * fq;
        const PG8_LAS float* tab = rstd_table(SS, u.pm, tid);
        bf16_t* dst = (t == 2) ? Qb : Kb + (size_t)t * ((size_t)M * D);
#pragma unroll
        for (int ai = 0; ai < 2; ++ai) {
            f32x4 cs[2][2];
#pragma unroll
            for (int bj = 0; bj < 2; ++bj)
#pragma unroll
                for (int n = 0; n < 2; ++n) cs[bj][n] = (f32x4){0.f, 0.f, 0.f, 0.f};
#pragma unroll
            for (int m = 0; m < 4; ++m) { const int rl = ai * HALF + wr * 64 + m * 16 + fr, row = u.pm * BM + rl; const float rs = tab[rl];
#pragma unroll
                for (int bj = 0; bj < 2; ++bj) { const f32x4 v0 = acc[ai][bj][m][0] * rs, v1 = acc[ai][bj][m][1] * rs; cs[bj][0] = cs[bj][0] + v0; cs[bj][1] = cs[bj][1] + v1;
                    u32x4 w; w.x = cvtpk(v0.x, v0.y); w.y = cvtpk(v0.z, v0.w); w.z = cvtpk(v1.x, v1.y); w.w = cvtpk(v1.z, v1.w);
                    *(u32x4*)(dst + (size_t)row * D + col0 + bj * HALF) = w; } }
            if (t == 0) {
#pragma unroll
                for (int bj = 0; bj < 2; ++bj)
#pragma unroll
                    for (int n = 0; n < 2; ++n) { f32x4 c = cs[bj][n];
                        c.x = row16_sum(c.x); c.y = row16_sum(c.y); c.z = row16_sum(c.z); c.w = row16_sum(c.w);
                        if (fr == 0) *(f32x4*)(KMP + ((size_t)u.pm * 4 + 2 * ai + wr) * D + col0 + bj * HALF + 4 * n) = c; }
            }
        }
    }
};

template <class Epi, class Sched>
__device__ __forceinline__ void gemm_phase(PG8_LAS unsigned char* lds, const Gemm g, const Sched& S, const Epi& E, const int tid) {
    const int wid = __builtin_amdgcn_readfirstlane(tid >> 6), lane = tid & 63, wr = wid >> 2, wc = wid & 3, fr = lane & 15, fq = lane >> 4;
    const int K = g.K, nt = K / BK, lda = g.lda;
    unsigned voffA[2], voffB[2];
#pragma unroll
    for (int i = 0; i < 2; ++i) { int R, C; stage_rc(tid * 16 + i * 8192, R, C); const int Rb = Epi::PERM ? ((R & ~31) + perm32(R & 31)) : R;
        voffA[i] = (unsigned)(R * lda + C) * 2u; voffB[i] = (unsigned)(Rb * K + C) * 2u; }
    const size_t kstep = (size_t)(BK * 2);
    const size_t hstepA = (size_t)HALF * lda * 2, hstepB = (size_t)HALF * K * 2;
    const size_t tstepA = 2 * hstepA, tstepB = 2 * hstepB;
    const size_t pnA = (size_t)g.a_pn_cols * 2;
    const unsigned ldsw = (unsigned)wid * 1024u;
    const int aoff[2] = {lds_byte(wr * 64 + fr, fq * 8), lds_byte(wr * 64 + fr, fq * 8 + 32)}, boff[2] = {lds_byte(wc * 32 + fr, fq * 8), lds_byte(wc * 32 + fr, fq * 8 + 32)};
#define PG8_SA(b, h) (((b) * 2 + (h)) * HTB)
#define PG8_SB(b, h) ((4 + (b) * 2 + (h)) * HTB)
#define PG8_STAGE(bufoff, gbase, voff) do { _Pragma("unroll") for (int _i = 0; _i < 2; ++_i) \
        __builtin_amdgcn_global_load_lds((const unsigned*)((const char*)(gbase) + (voff)[_i]), (PG8_LAS unsigned*)(lds + (bufoff) + ldsw + _i * 8192), 16, 0, 0); } while (0)
#define PG8_LDA(dst, b, h) do { _Pragma("unroll") for (int m = 0; m < 4; ++m) _Pragma("unroll") for (int k = 0; k < 2; ++k) dst[m][k] = *(const PG8_LAS bf16x8*)(lds + PG8_SA(b, h) + aoff[k] + m * 2048); } while (0)
#define PG8_LDB(dst, b, h) do { _Pragma("unroll") for (int n = 0; n < 2; ++n) _Pragma("unroll") for (int k = 0; k < 2; ++k) dst[n][k] = *(const PG8_LAS bf16x8*)(lds + PG8_SB(b, h) + boff[k] + n * 2048); } while (0)
#define PG8_MMA(ai, bj, At, Bt) do { __builtin_amdgcn_s_setprio(1); _Pragma("unroll") for (int m = 0; m < 4; ++m) _Pragma("unroll") for (int n = 0; n < 2; ++n) _Pragma("unroll") for (int k = 0; k < 2; ++k) \
        acc[ai][bj][m][n] = __builtin_amdgcn_mfma_f32_16x16x32_bf16(Bt[n][k], At[m][k], acc[ai][bj][m][n], 0, 0, 0); __builtin_amdgcn_s_setprio(0); } while (0)
#define PG8_WAIT_V(n) asm volatile("s_waitcnt vmcnt(" #n ")" ::: "memory")
#define PG8_WAIT_L(n) asm volatile("s_waitcnt lgkmcnt(" #n ")" ::: "memory")
#define PG8_BAR __builtin_amdgcn_s_barrier()
#define PG8_SCHED __builtin_amdgcn_sched_barrier(0)
    Unit cur, nxt; int ui = 0;
    if (!S.next(0, cur)) return;
    f32x4 acc[2][2][4][2];
#pragma unroll
    for (int a = 0; a < 2; ++a)
#pragma unroll
        for (int b = 0; b < 2; ++b)
#pragma unroll
            for (int m = 0; m < 4; ++m)
#pragma unroll
                for (int n = 0; n < 2; ++n) acc[a][b][m][n] = (f32x4){0.f, 0.f, 0.f, 0.f};
    bf16x8 At[4][2], B0[2][2], B1[2][2];
    const char* cA = (const char*)g.A + (size_t)cur.pm * tstepA + (size_t)cur.pn * pnA + (cur.hm > 0 ? hstepA : 0); const char* cB = (const char*)g.Bt + (size_t)cur.pn * tstepB;
    size_t chs = cur.hm < 0 ? hstepA : 0;
    PG8_STAGE(PG8_SB(0, 0), cB, voffB); PG8_STAGE(PG8_SB(0, 1), cB + hstepB, voffB); PG8_STAGE(PG8_SA(0, 0), cA, voffA); PG8_STAGE(PG8_SA(0, 1), cA + chs, voffA);
    if (wr == 1) PG8_BAR;
    PG8_WAIT_V(2); PG8_BAR;
    PG8_STAGE(PG8_SB(1, 0), cB + kstep, voffB); PG8_STAGE(PG8_SA(1, 0), cA + kstep, voffA); PG8_STAGE(PG8_SB(1, 1), cB + hstepB + kstep, voffB);
    PG8_WAIT_V(6); PG8_BAR;
    for (;;) {
        const bool has_next = S.next(ui + 1, nxt);
        const char* nA = has_next ? (const char*)g.A + (size_t)nxt.pm * tstepA + (size_t)nxt.pn * pnA + (nxt.hm > 0 ? hstepA : 0) : cA; const char* nB = has_next ? (const char*)g.Bt + (size_t)nxt.pn * tstepB : cB;
        const size_t nhs = has_next ? (nxt.hm < 0 ? hstepA : 0) : chs; const bool fullu = cur.hm < 0;
        for (int t = 0; t < nt; t += 2) {
            const bool last = (t == nt - 2);
            const char* a1 = cA + (size_t)(t + 1) * kstep;
            const char* a2 = last ? nA : cA + (size_t)(t + 2) * kstep; const char* b2 = last ? nB : cB + (size_t)(t + 2) * kstep;
            const char* a3 = a2 + kstep; const char* b3 = b2 + kstep;
            PG8_LDB(B0, 0, 0); PG8_LDB(B1, 0, 1); PG8_SCHED; PG8_LDA(At, 0, 0); PG8_STAGE(PG8_SA(1, 1), a1 + chs, voffA);
            PG8_WAIT_V(8); PG8_WAIT_L(0); PG8_BAR; PG8_MMA(0, 0, At, B0); PG8_MMA(0, 1, At, B1); PG8_BAR; PG8_SCHED;
            PG8_LDA(At, 0, 1); PG8_STAGE(PG8_SB(0, 0), b2, voffB); PG8_STAGE(PG8_SB(0, 1), b2 + hstepB, voffB); PG8_STAGE(PG8_SA(0, 0), a2, voffA);
            PG8_WAIT_V(8); PG8_WAIT_L(0); PG8_BAR; if (fullu) { PG8_MMA(1, 0, At, B0); PG8_MMA(1, 1, At, B1); } PG8_BAR; PG8_SCHED;
            PG8_LDB(B0, 1, 0); PG8_LDB(B1, 1, 1); PG8_SCHED; PG8_LDA(At, 1, 0); PG8_STAGE(PG8_SA(0, 1), a2 + (last ? nhs : chs), voffA);
            PG8_WAIT_V(8); PG8_WAIT_L(0); PG8_BAR; PG8_MMA(0, 0, At, B0); PG8_MMA(0, 1, At, B1); PG8_BAR; PG8_SCHED;
            PG8_LDA(At, 1, 1); PG8_STAGE(PG8_SB(1, 0), b3, voffB); PG8_STAGE(PG8_SB(1, 1), b3 + hstepB, voffB); PG8_STAGE(PG8_SA(1, 0), a3, voffA);
            PG8_WAIT_V(8); PG8_WAIT_L(0); PG8_BAR; if (fullu) { PG8_MMA(1, 0, At, B0); PG8_MMA(1, 1, At, B1); } PG8_BAR; PG8_SCHED;
        }
        if (wr == 0) PG8_BAR;
        E(acc, cur, wr, wc, fr, fq);
        if (!has_next) break;
#pragma unroll
        for (int a = 0; a < 2; ++a)
#pragma unroll
            for (int b = 0; b < 2; ++b)
#pragma unroll
                for (int m = 0; m < 4; ++m)
#pragma unroll
                    for (int n = 0; n < 2; ++n) acc[a][b][m][n] = (f32x4){0.f, 0.f, 0.f, 0.f};
        cur = nxt; cA = nA; cB = nB; chs = nhs; ++ui;
        if (wr == 1) PG8_BAR;
    }
    PG8_WAIT_V(0);
    PG8_BAR;
#undef PG8_SA
#undef PG8_SB
#undef PG8_STAGE
#undef PG8_LDA
#undef PG8_LDB
#undef PG8_MMA
#undef PG8_WAIT_V
#undef PG8_WAIT_L
#undef PG8_BAR
#undef PG8_SCHED
}
}
namespace poolf {
using namespace pg8;
template <int W> __device__ __forceinline__ void build_d(PG8_LAS unsigned char* lds, const bf16_t* X, const float* SS, int pm, int g, int ai, int wid, int lane) {
    constexpr int NR = 16 + W - 1;
    const int hw = lane >> 5, l32 = lane & 31;
    const int bq = pm >> 3, t0 = (pm & 7) * 256 + 128 * ai + 16 * wid;
    const int c0 = 256 * g + 128 * hw + 4 * l32;
    float rs = 0.f; { const int t = t0 - (W - 1) + l32; if (l32 < NR && t >= 0) rs = row_rstd(SS, bq * SEQ + t); }
    f32x4 v[NR]; u32x2 wraw[NR];
#pragma unroll
    for (int i = 0; i < NR; ++i) { const int t = t0 - (W - 1) + i, tc = t < 0 ? 0 : t;
        wraw[i] = *(const u32x2*)(X + (size_t)(bq * SEQ + tc) * D + c0); }
    __builtin_amdgcn_sched_barrier(0);
#pragma unroll
    for (int i = 0; i < NR; ++i) { const float r = lane_bcast(rs, i); v[i] = (f32x4){bf_lo(wraw[i].x), bf_hi(wraw[i].x), bf_lo(wraw[i].y), bf_hi(wraw[i].y)} * r; }
    f32x4 S = (f32x4){0.f, 0.f, 0.f, 0.f};
#pragma unroll
    for (int i = 0; i < W - 1; ++i) S = S + v[i];
    const int kt = 2 * hw + (l32 >> 4), cc = (4 * l32) & 63;
#pragma unroll
    for (int r = 0; r < 16; ++r) { const int i = r + W - 1; S = S + v[i]; const int t = t0 + r; const float cnt = (float)((t + 1) < W ? (t + 1) : W);
        const f32x4 d = S * __builtin_amdgcn_rcpf(cnt) - v[i];     u32x2 w; w.x = cvtpk(d.x, d.y); w.y = cvtpk(d.z, d.w);
        *(PG8_LAS u32x2*)(lds + kt * HTB + lds_byte(16 * wid + r, cc)) = w; S = S - v[r]; }
}
__device__ __forceinline__ void build_d_dispatch(PG8_LAS unsigned char* lds, const bf16_t* X, const float* SS, int pm, int g, int ai, int wid, int lane) {
    if (g == 0) build_d<2>(lds, X, SS, pm, 0, ai, wid, lane); else if (g == 1) build_d<4>(lds, X, SS, pm, 1, ai, wid, lane);
    else if (g == 2) build_d<8>(lds, X, SS, pm, 2, ai, wid, lane); else build_d<16>(lds, X, SS, pm, 3, ai, wid, lane);
}
__device__ __forceinline__ void pool_phase(PG8_LAS unsigned char* lds, const bf16_t* XB, const float* SS, const bf16_t* Wp, const StaticOrder& S, const EpiResid& E, const int tid) {
    const int wid = __builtin_amdgcn_readfirstlane(tid >> 6), lane0 = tid & 63, wr = wid >> 2, wc = wid & 3;
    constexpr int K = 256;
    const unsigned ldsw = (unsigned)wid * 1024u;
    Unit u;
    for (int ui = 0; S.next(ui, u); ++ui) {
        const char* cB = (const char*)Wp + (size_t)u.pn * 256 * K * 2;
        for (int ai = 0; ai < 2; ++ai) {
            int lane = lane0; asm volatile("" : "+v"(lane)); const int fr = lane & 15, fq = lane >> 4, tidl = wid * 64 + lane;
            unsigned voffB[2];
#pragma unroll
            for (int i = 0; i < 2; ++i) { int R, C; stage_rc(tidl * 16 + i * 8192, R, C); const int Rb = (R & ~31) + perm32(R & 31); voffB[i] = (unsigned)(Rb * K + C) * 2u; }
#pragma unroll
            for (int kt = 0; kt < 4; ++kt)
#pragma unroll
                for (int i = 0; i < 2; ++i)
                    __builtin_amdgcn_global_load_lds((const unsigned*)(cB + (size_t)kt * (BK * 2) + voffB[i]), (PG8_LAS unsigned*)(lds + (4 + kt) * HTB + ldsw + i * 8192), 16, 0, 0);
            build_d_dispatch(lds, XB, SS, u.pm, u.pn, ai, wid, lane);
            const int aoff[2] = {lds_byte(wr * 64 + fr, fq * 8), lds_byte(wr * 64 + fr, fq * 8 + 32)}, boff[2] = {lds_byte(wc * 32 + fr, fq * 8), lds_byte(wc * 32 + fr, fq * 8 + 32)};
            f32x4 acc[2][4][2]; u32x4 xb[4][2];
#pragma unroll
            for (int bj = 0; bj < 2; ++bj) {
                if (bj == 1) {
#pragma unroll
                    for (int kt = 0; kt < 4; ++kt)
#pragma unroll
                        for (int i = 0; i < 2; ++i)
                            __builtin_amdgcn_global_load_lds((const unsigned*)(cB + (size_t)HALF * K * 2 + (size_t)kt * (BK * 2) + voffB[i]), (PG8_LAS unsigned*)(lds + (4 + kt) * HTB + ldsw + i * 8192), 16, 0, 0);
                    __builtin_amdgcn_sched_barrier(0); E.rows_load(xb, u, ai, wr, wc, fr, fq); __builtin_amdgcn_sched_barrier(0);
                    asm volatile("s_waitcnt vmcnt(8) lgkmcnt(0)" ::: "memory"); __builtin_amdgcn_s_barrier(); asm volatile("" ::: "memory");
                } else {
                asm volatile("s_waitcnt vmcnt(0) lgkmcnt(0)" ::: "memory"); __builtin_amdgcn_s_barrier(); asm volatile("" ::: "memory");
                }
#pragma unroll
                for (int m = 0; m < 4; ++m)
#pragma unroll
                    for (int n = 0; n < 2; ++n) acc[bj][m][n] = (f32x4){0.f, 0.f, 0.f, 0.f};
#pragma unroll
                for (int kt = 0; kt < 4; ++kt) {
                    bf16x8 At[4][2], Bt[2][2];
#pragma unroll
                    for (int n = 0; n < 2; ++n)
#pragma unroll
                        for (int k = 0; k < 2; ++k) Bt[n][k] = *(const PG8_LAS bf16x8*)(lds + (4 + kt) * HTB + boff[k] + n * 2048);
#pragma unroll
                    for (int m = 0; m < 4; ++m)
#pragma unroll
                        for (int k = 0; k < 2; ++k) At[m][k] = *(const PG8_LAS bf16x8*)(lds + kt * HTB + aoff[k] + m * 2048);
#pragma unroll
                    for (int m = 0; m < 4; ++m)
#pragma unroll
                        for (int n = 0; n < 2; ++n)
#pragma unroll
                            for (int k = 0; k < 2; ++k) acc[bj][m][n] = __builtin_amdgcn_mfma_f32_16x16x32_bf16(Bt[n][k], At[m][k], acc[bj][m][n], 0, 0, 0);
                }
                asm volatile("s_waitcnt lgkmcnt(0)" ::: "memory"); __builtin_amdgcn_s_barrier(); asm volatile("" ::: "memory");
            }
            E.rows_finish(acc, xb, u, ai, wr, wc, fr, fq);
        }
    }
}
}
#include <hip/hip_bf16.h>
#include <cmath>
namespace attn_body {
using bf16=__hip_bfloat16;
using bf16x8=__attribute__((ext_vector_type(8)))short;
using s16x4=__attribute__((ext_vector_type(4)))short;
using f32x16=__attribute__((ext_vector_type(16)))float;
using u32x4=__attribute__((ext_vector_type(4)))unsigned;
using f32x4=__attribute__((ext_vector_type(4)))float;
constexpr int NHEAD=16,SEQ=2048,D=64,DM=NHEAD*D;
constexpr int NW=8,QBLK=32,QB=QBLK*NW,KVBLK=64;
__device__ __forceinline__ int crow(int r,int hi){return (r&3)+8*(r>>2)+4*hi;}
#define SBAR() __builtin_amdgcn_sched_barrier(0)
typedef __attribute__((address_space(3))) const float* lds_fptr;
__device__ __forceinline__ void bias_load(f32x16&b0,f32x16&b1,int dl,int hi,lds_fptr bt){
  const lds_fptr pb=bt+(dl-4*hi+69);
  #pragma unroll
  for(int r=0;r<16;++r){ const int c=(r&3)+8*(r>>2); b0[r]=pb[59-c]; b1[r]=pb[27-c]; }
}

constexpr int NSLOT=3, SLOTB=8192;
constexpr int LDS_K=0, LDS_V=NSLOT*SLOTB, LDS_WS=2*NSLOT*SLOTB, LDS_OST=LDS_WS+NW*64*4, LDS_BT=LDS_OST+NW*4096, LDS_KM=LDS_BT+2560, LDS_QP=LDS_KM+2048, LDS_BYTES=LDS_QP+4*8192;
__device__ __forceinline__ void glds16(const void*sbase,unsigned voff,unsigned lds_dst){unsigned keep;
  asm volatile("s_mov_b32 %0, m0\n\ts_mov_b32 m0, %3\n\ts_nop 0\n\tglobal_load_lds_dwordx4 %1, %2\n\ts_mov_b32 m0, %0":"=&s"(keep):"v"(voff),"s"(sbase),"s"(lds_dst):"memory");}
__device__ __forceinline__ float max3f(float a,float b,float c){float r;asm("v_max3_f32 %0, %1, %2, %3":"=v"(r):"v"(a),"v"(b),"v"(c));return r;}
__device__ __forceinline__ float max2f(float a,float b){float r;asm("v_max_f32_e32 %0, %1, %2":"=v"(r):"v"(a),"v"(b));return r;}
__device__ __forceinline__ float fadd_s(float a,float b){float r;asm("v_add_f32_e32 %0, %1, %2":"=v"(r):"v"(a),"v"(b));return r;}
__device__ __forceinline__ float fsub_s(float a,float b){float r;asm("v_sub_f32_e32 %0, %1, %2":"=v"(r):"v"(a),"v"(b));return r;}
typedef float f32x2_t __attribute__((ext_vector_type(2))); typedef __bf16 bf16x2_t __attribute__((ext_vector_type(2)));
__device__ __forceinline__ unsigned cvtpk_s(float lo,float hi){f32x2_t v={lo,hi};bf16x2_t b=__builtin_convertvector(v,bf16x2_t);return __builtin_bit_cast(unsigned,b);}
#define WAIT_BAR(N) asm volatile("s_waitcnt vmcnt(" #N ") lgkmcnt(0)\n\ts_barrier":::"memory")

__device__ __forceinline__ void qkt(f32x16&p0,f32x16&p1,const char*Kslot,const bf16x8*qr,const f32x16 i0,const f32x16 i1,int r32,int hi){
  const char*kb=Kslot+hi*1024+r32*16;
  #pragma unroll
  for(int d0=0;d0<4;++d0){
    const bf16x8 b0=*reinterpret_cast<const bf16x8*>(kb+d0*2048);
    const bf16x8 b1=*reinterpret_cast<const bf16x8*>(kb+d0*2048+512);
    if(d0==0){p0=__builtin_amdgcn_mfma_f32_32x32x16_bf16(b0,qr[0],i0,0,0,0);p1=__builtin_amdgcn_mfma_f32_32x32x16_bf16(b1,qr[0],i1,0,0,0);}
    else{p0=__builtin_amdgcn_mfma_f32_32x32x16_bf16(b0,qr[d0],p0,0,0,0);p1=__builtin_amdgcn_mfma_f32_32x32x16_bf16(b1,qr[d0],p1,0,0,0);}}
}
typedef __attribute__((address_space(3))) const char* lds_cptr;
typedef short v4i16_t __attribute__((ext_vector_type(4)));
__device__ __forceinline__ void kload8(bf16x8*kf,lds_cptr kp){
  kf[0]=*(const __attribute__((address_space(3))) bf16x8*)(kp);      kf[1]=*(const __attribute__((address_space(3))) bf16x8*)(kp+512);
  kf[2]=*(const __attribute__((address_space(3))) bf16x8*)(kp+2048); kf[3]=*(const __attribute__((address_space(3))) bf16x8*)(kp+2560);
  kf[4]=*(const __attribute__((address_space(3))) bf16x8*)(kp+4096); kf[5]=*(const __attribute__((address_space(3))) bf16x8*)(kp+4608);
  kf[6]=*(const __attribute__((address_space(3))) bf16x8*)(kp+6144); kf[7]=*(const __attribute__((address_space(3))) bf16x8*)(kp+6656);
}
__device__ __forceinline__ void kload2(bf16x8*kf,lds_cptr kp,int j){ kf[2*j]=*(const __attribute__((address_space(3))) bf16x8*)(kp+j*2048); kf[2*j+1]=*(const __attribute__((address_space(3))) bf16x8*)(kp+j*2048+512); }
__device__ __forceinline__ s16x4 vtr(lds_cptr p){ return __builtin_bit_cast(s16x4,__builtin_amdgcn_ds_read_tr16_b64_v4i16((__attribute__((address_space(3))) v4i16_t*)p)); }
__device__ __forceinline__ float rowmax(const f32x16&p0,const f32x16&p1){
  float a=max3f(p0[0],p0[1],p1[0]),b=max3f(p0[2],p0[3],p1[1]);a=max3f(a,p1[2],p1[3]);
  #pragma unroll
  for(int r=4;r<16;r+=4){a=max3f(a,p0[r],p0[r+1]);b=max3f(b,p0[r+2],p0[r+3]);a=max3f(a,p1[r],p1[r+1]);b=max3f(b,p1[r+2],p1[r+3]);}
  const float m=max2f(a,b);
  auto rr=__builtin_amdgcn_permlane32_swap(__float_as_uint(m),__float_as_uint(m),false,false);
  return max2f(__uint_as_float(rr[0]),__uint_as_float(rr[1]));
}
__device__ __forceinline__ void pv(f32x16*o,int vb,bf16x8 pa0,bf16x8 pa1,bf16x8 pa2,bf16x8 pa3){
  #pragma unroll
  for(int d0=0;d0<2;++d0){s16x4 lo[4],hi[4];
    #pragma unroll
    for(int ks=0;ks<4;++ks){
      asm volatile("ds_read_b64_tr_b16 %0,%1 offset:%c2":"=&v"(lo[ks]):"v"(vb),"i"(d0*4096+ks*1024):"memory");
      asm volatile("ds_read_b64_tr_b16 %0,%1 offset:%c2":"=&v"(hi[ks]):"v"(vb),"i"(d0*4096+ks*1024+512):"memory");}
    asm volatile("s_waitcnt lgkmcnt(0)":::"memory");SBAR();
    #define PK(k) (bf16x8){lo[k][0],lo[k][1],lo[k][2],lo[k][3],hi[k][0],hi[k][1],hi[k][2],hi[k][3]}
    o[d0]=__builtin_amdgcn_mfma_f32_32x32x16_bf16(pa0,PK(0),o[d0],0,0,0);
    o[d0]=__builtin_amdgcn_mfma_f32_32x32x16_bf16(pa1,PK(1),o[d0],0,0,0);
    o[d0]=__builtin_amdgcn_mfma_f32_32x32x16_bf16(pa2,PK(2),o[d0],0,0,0);
    o[d0]=__builtin_amdgcn_mfma_f32_32x32x16_bf16(pa3,PK(3),o[d0],0,0,0);
    #undef PK
  }
}

#ifndef ATTN_STORE16
#define ATTN_STORE16(p,v) (*(u32x4*)(p)=(v))
#endif
template<int THRL,bool NOFIX=false> __device__ __forceinline__ void attn_unit(int b,int h,int own,const bf16*Q,const bf16*__restrict__ K,const bf16*__restrict__ V,bf16*O,const float*KMP,const float*biasT,char*shm,const int wid){
  int lane=__builtin_amdgcn_mbcnt_hi(~0u,__builtin_amdgcn_mbcnt_lo(~0u,0u)); asm volatile("":"+v"(lane));
  const int tid=wid*64+lane,r32=lane&31,hi=lane>>5;
  const long rowbase=(long)b*SEQ; const int q0=own*QB;
  const bf16*Qw=Q+(rowbase+q0+wid*QBLK)*DM+h*D;
  const bf16*Kh=K+rowbase*DM+h*D,*Vh=V+rowbase*DM+h*D;
  const unsigned lds0=(unsigned)(uintptr_t)shm;
  float*wsf=(float*)(shm+LDS_WS)+wid*64;
  const lds_cptr shm3=(lds_cptr)shm;
  const lds_fptr bt=(lds_fptr)(shm3+LDS_BT);
  const lds_fptr km=(lds_fptr)(shm3+LDS_KM);
  { typedef __attribute__((address_space(3))) float* lds_wptr; const lds_wptr btw=(lds_wptr)(shm3+LDS_BT), kmw=(lds_wptr)(shm3+LDS_KM);
    for(int e=tid;e<640;e+=512){ const int d=e-128; btw[e]=d<0?-INFINITY:(d<128?biasT[h*128+d]:0.f); }
    const int j=tid>>6,d=tid&63;
    if(j<own){ const float*kp=KMP+((size_t)(b*8+j)*4)*1024+h*64+d; kmw[j*64+d]=(kp[0]+kp[1024])+(kp[2048]+kp[3072]); } }
  #define KT(i) (((i)<4)?(4*own+(i)):((i)-4))
  const unsigned koff=(unsigned)(lane*DM+wid*8)*2u;
  const unsigned voff=(unsigned)((16*(wid&3)+(lane>>2))*DM+(wid>>2)*32+(lane&3)*8)*2u;
  const unsigned kdst=lds0+LDS_K+wid*1024, vdst=lds0+LDS_V+wid*1024;
  #define DMA_K(t,slot) glds16(Kh+(long)KT(t)*KVBLK*DM,koff,(unsigned)__builtin_amdgcn_readfirstlane(kdst+(slot)))
  #define DMA_V(t,slot) glds16(Vh+(long)KT(t)*KVBLK*DM,voff,(unsigned)__builtin_amdgcn_readfirstlane(vdst+(slot)))
  const char*Kbase=shm+LDS_K; bf16x8 kf[8];
  const lds_cptr kp0=shm3+LDS_K+hi*1024+r32*16; const lds_cptr vp0=shm3+LDS_V+((lane>>4)&1)*32+(lane&3)*8+(4*hi+((lane&15)>>2))*64;
  const int NT=4*own+4;
  DMA_K(0,0);DMA_V(0,0);DMA_K(1,SLOTB);
  bf16x8 qr[4];
  #pragma unroll
  for(int d0=0;d0<4;++d0)qr[d0]=__builtin_nontemporal_load(reinterpret_cast<const bf16x8*>(&Qw[(long)r32*DM+d0*16+hi*8]));
  float mhat=0.f,l_reg=0.f;f32x16 o[2];o[0]=f32x16{};o[1]=f32x16{};const f32x16 zero16=f32x16{};
  #define qrel (wid*QBLK+r32)
  unsigned selmask=(own<=3)?((1u<<own)-1u):0u;
  #define KEEPF(t,KEEP) do{ if(NOFIX)break; const int t_=(t); \
      if(t_<4){ if(64*t_>32*wid+31) KEEP=false; } else { KEEP=(selmask>>((t_-4)>>2))&1u; } }while(0)
  #define NEEDB(t,NB,B0,B1) do{ NB=false; if(NOFIX)break; const int t_=(t); int dl_=0; \
      if(t_<4){ if(64*t_<=32*wid+31&&32*wid-64*t_-63<113){ NB=true; dl_=qrel-64*t_; } } \
      else if(t_<NT){ const int j_=(t_-4)>>2, tt_=(t_-4)&3; if(j_==own-1&&(256+32*wid-64*tt_-63<113)){ NB=true; dl_=256+qrel-64*tt_; } } \
      if(NB) bias_load(B0,B1,dl_,hi,bt); }while(0)
  bool resc=false;
  #define START(P0,P1) do{ const float rm=rowmax(P0,P1); resc=false; \
    { const float dl=rm; mhat=fadd_s(mhat,dl); \
      _Pragma("unroll") for(int r=0;r<16;++r){P0[r]=fsub_s(P0[r],dl);P1[r]=fsub_s(P1[r],dl);} } \
    _Pragma("unroll") for(int r=0;r<16;++r)P0[r]=__builtin_amdgcn_exp2f(P0[r]); }while(0)
  #define RESC() do{ if(resc){ asm volatile("s_waitcnt lgkmcnt(0)":::"memory"); \
      _Pragma("unroll") for(int d_=0;d_<2;++d_) _Pragma("unroll") for(int r=0;r<16;++r)o[d_][r]*=wsf[crow(r,hi)]; } }while(0)
  int sl_prev=0,sl_cur=0,sl_next=SLOTB;
  #define ROT() do{sl_prev=sl_cur;sl_cur=sl_next;sl_next=(sl_next==(NSLOT-1)*SLOTB)?0:sl_next+SLOTB;}while(0)
  DMA_K(2,2*SLOTB);
  WAIT_BAR(3);
  if(own>=4){
    float b0=-INFINITY,b1=-INFINITY,b2=-INFINITY; int i0=0,i1=0,i2=0;
    for(int j=0;j<own;++j){ float g=0.f;
      #pragma unroll
      for(int d0=0;d0<4;++d0){ const f32x4 ka=*(const __attribute__((address_space(3))) f32x4*)(km+j*64+d0*16+hi*8), kb2=*(const __attribute__((address_space(3))) f32x4*)(km+j*64+d0*16+hi*8+4);
        const bf16x8 qv=qr[d0];
        g+=__uint_as_float((unsigned)(unsigned short)qv[0]<<16)*ka.x; g+=__uint_as_float((unsigned)(unsigned short)qv[1]<<16)*ka.y; g+=__uint_as_float((unsigned)(unsigned short)qv[2]<<16)*ka.z; g+=__uint_as_float((unsigned)(unsigned short)qv[3]<<16)*ka.w;
        g+=__uint_as_float((unsigned)(unsigned short)qv[4]<<16)*kb2.x; g+=__uint_as_float((unsigned)(unsigned short)qv[5]<<16)*kb2.y; g+=__uint_as_float((unsigned)(unsigned short)qv[6]<<16)*kb2.z; g+=__uint_as_float((unsigned)(unsigned short)qv[7]<<16)*kb2.w; }
      { auto rr=__builtin_amdgcn_permlane32_swap(__float_as_uint(g),__float_as_uint(g),false,false); g=__uint_as_float(rr[0])+__uint_as_float(rr[1]); }
      if(g>b0){b2=b1;i2=i1;b1=b0;i1=i0;b0=g;i0=j;} else if(g>b1){b2=b1;i2=i1;b1=g;i1=j;} else if(g>b2){b2=g;i2=j;} }
    selmask=(1u<<i0)|(1u<<i1)|(1u<<i2);
  }
  #define PKW(P,B) cvtpk_s(P[B],P[B+1])
  #define PK4(P,B) (u32x4){PKW(P,B),PKW(P,B+2),PKW(P,B+4),PKW(P,B+6)}
  u32x4 pwA0,pwA1,pwA2,pwA3,pwB0,pwB1,pwB2,pwB3;
  { f32x16 c0,c1;
    bool nb0_; NEEDB(0,nb0_,c0,c1); if(!nb0_){c0=zero16;c1=zero16;}
    qkt(c0,c1,Kbase,qr,c0,c1,r32,hi);asm volatile("s_nop 15\n\ts_nop 7":"+v"(c0),"+v"(c1));
    START(c0,c1);
    _Pragma("unroll") for(int r=0;r<16;++r)c1[r]=__builtin_amdgcn_exp2f(c1[r]);
    float sacc=c0[0]+c0[1]; _Pragma("unroll") for(int r=2;r<16;++r)sacc+=c0[r]; _Pragma("unroll") for(int r=0;r<16;++r)sacc+=c1[r]; l_reg+=sacc;
    pwA0=PK4(c0,0);pwA1=PK4(c0,8);pwA2=PK4(c1,0);pwA3=PK4(c1,8); }
  const __attribute__((address_space(3))) bf16x8* qlp=(const __attribute__((address_space(3))) bf16x8*)(shm3+LDS_QP)+tid;
  { __attribute__((address_space(3))) bf16x8* qw=(__attribute__((address_space(3))) bf16x8*)(shm3+LDS_QP)+tid;
    _Pragma("unroll") for(int d0=0;d0<4;++d0) qw[d0*512]=qr[d0]; }
  #define QL(d0) qlp[(d0)*512]
  bf16x8 qa=QL(0),qb=QL(1);
  WAIT_BAR(0);
  DMA_K(3,0);DMA_V(1,SLOTB);
  ROT();
  kload8(kf,kp0+sl_cur);
  WAIT_BAR(2);
  s16x4 vlo[8],vhi[8];
  #define PAFV(v) __builtin_bit_cast(bf16x8,v)
  #define VFR(i) (bf16x8){vlo[i][0],vlo[i][1],vlo[i][2],vlo[i][3],vhi[i][0],vhi[i][1],vhi[i][2],vhi[i][3]}
  #define PIN(x) asm volatile("":"+v"(x))
  #define MX3(a,b,c) __builtin_fmaxf(__builtin_fmaxf((a),(b)),(c))
  #define GAPA(MF) do{ MF; SBAR(); }while(0)
  #define EX(v) __builtin_amdgcn_exp2f(v)
  #define GAPB(MF,X,B,PK) do{ MF; X[B]=EX(X[B]); X[B+1]=EX(X[B+1]); X[B+2]=EX(X[B+2]); X[B+3]=EX(X[B+3]); sacc+=X[B]; sacc+=X[B+1]; sacc+=X[B+2]; sacc+=X[B+3]; PIN(sacc); PIN(X); PK; SBAR(); }while(0)
  #define VRD(i) do{ vlo[i]=vtr(vp_+(((i)>>2)*4096+((i)&3)*1024)); vhi[i]=vtr(vp_+(((i)>>2)*4096+((i)&3)*1024+512)); }while(0)
  #define KRD(j) do{ kload2(kf,kp0+sl_next,j); SBAR(); }while(0)
  #define STEP(I0,I1,I2,I3,O0,O1,O2,O3,t,GK,GV) do{ SBAR(); \
    const lds_cptr vp_=vp0+sl_prev; f32x16 C0,C1; bool nb; NEEDB(t,nb,C0,C1); \
    VRD(0); SBAR(); \
    if(nb){ GAPA(C0=__builtin_amdgcn_mfma_f32_32x32x16_bf16(kf[0],qa,C0,0,0,0)); VRD(4); SBAR(); GAPA(C1=__builtin_amdgcn_mfma_f32_32x32x16_bf16(kf[1],qa,C1,0,0,0)); } \
    else  { GAPA(C0=__builtin_amdgcn_mfma_f32_32x32x16_bf16(kf[0],qa,zero16,0,0,0)); VRD(4); SBAR(); GAPA(C1=__builtin_amdgcn_mfma_f32_32x32x16_bf16(kf[1],qa,zero16,0,0,0)); } \
    qa=QL(2); VRD(1); SBAR(); GAPA(C0=__builtin_amdgcn_mfma_f32_32x32x16_bf16(kf[2],qb,C0,0,0,0)); \
    VRD(5); SBAR(); GAPA(C1=__builtin_amdgcn_mfma_f32_32x32x16_bf16(kf[3],qb,C1,0,0,0)); \
    qb=QL(3); VRD(2); SBAR(); GAPA(C0=__builtin_amdgcn_mfma_f32_32x32x16_bf16(kf[4],qa,C0,0,0,0)); \
    VRD(6); SBAR(); GAPA(C1=__builtin_amdgcn_mfma_f32_32x32x16_bf16(kf[5],qa,C1,0,0,0)); \
    VRD(3); SBAR(); GAPA(C0=__builtin_amdgcn_mfma_f32_32x32x16_bf16(kf[6],qb,C0,0,0,0)); \
    VRD(7); SBAR(); GAPA(C1=__builtin_amdgcn_mfma_f32_32x32x16_bf16(kf[7],qb,C1,0,0,0)); \
    if(GK){DMA_K((t)+3,sl_cur);} if(GV){DMA_V((t)+1,sl_next);} \
    bool keep_=true; KEEPF(t,keep_); \
    { float a=MX3(C0[0],C0[1],C1[0]),b=MX3(C0[2],C0[3],C1[1]); a=MX3(a,C1[2],C1[3]); \
      _Pragma("unroll") for(int r=4;r<16;r+=4){a=MX3(a,C0[r],C0[r+1]);b=MX3(b,C0[r+2],C0[r+3]);a=MX3(a,C1[r],C1[r+1]);b=MX3(b,C1[r+2],C1[r+3]);} \
      float rm=__builtin_fmaxf(a,b); { auto rr=__builtin_amdgcn_permlane32_swap(__float_as_uint(rm),__float_as_uint(rm),false,false); rm=__builtin_fmaxf(__uint_as_float(rr[0]),__uint_as_float(rr[1])); } \
      rm=keep_?rm-mhat:-INFINITY; resc=false; \
      if(__builtin_expect(__any(rm>(float)THRL),0)){ const float dl=__builtin_fmaxf(rm,0.f); mhat+=dl; \
        const float f=__builtin_amdgcn_exp2f(-dl); l_reg*=f; if(hi==0)wsf[r32]=f; resc=true; } \
      const float msub=keep_?mhat:INFINITY; \
      _Pragma("unroll") for(int r=0;r<16;++r){C0[r]-=msub;C1[r]-=msub;} } \
    SBAR(); float sacc=0.f; \
    GAPB(o[0]=__builtin_amdgcn_mfma_f32_32x32x16_bf16(PAFV(I0),VFR(0),o[0],0,0,0), C0,0, ); \
    GAPB(o[1]=__builtin_amdgcn_mfma_f32_32x32x16_bf16(PAFV(I0),VFR(4),o[1],0,0,0), C0,4, ); \
    KRD(0); GAPB(o[0]=__builtin_amdgcn_mfma_f32_32x32x16_bf16(PAFV(I1),VFR(1),o[0],0,0,0), C0,8,  O0[0]=PKW(C0,0);O0[1]=PKW(C0,2);PIN(O0)); \
    KRD(1); GAPB(o[1]=__builtin_amdgcn_mfma_f32_32x32x16_bf16(PAFV(I1),VFR(5),o[1],0,0,0), C0,12, O0[2]=PKW(C0,4);O0[3]=PKW(C0,6);PIN(O0)); \
    KRD(2); GAPB(o[0]=__builtin_amdgcn_mfma_f32_32x32x16_bf16(PAFV(I2),VFR(2),o[0],0,0,0), C1,0,  O1[0]=PKW(C0,8);O1[1]=PKW(C0,10);PIN(O1)); \
    KRD(3); GAPB(o[1]=__builtin_amdgcn_mfma_f32_32x32x16_bf16(PAFV(I2),VFR(6),o[1],0,0,0), C1,4,  O1[2]=PKW(C0,12);O1[3]=PKW(C0,14);PIN(O1)); \
    GAPB(o[0]=__builtin_amdgcn_mfma_f32_32x32x16_bf16(PAFV(I3),VFR(3),o[0],0,0,0), C1,8,  O2[0]=PKW(C1,0);O2[1]=PKW(C1,2);PIN(O2)); \
    GAPB(o[1]=__builtin_amdgcn_mfma_f32_32x32x16_bf16(PAFV(I3),VFR(7),o[1],0,0,0), C1,12, O2[2]=PKW(C1,4);O2[3]=PKW(C1,6);PIN(O2)); \
    O3=PK4(C1,8); l_reg+=sacc; qa=QL(0); qb=QL(1); \
    }while(0)
  #define ENDW(tt) do{ if((tt)+3<NT){WAIT_BAR(2);} else if((tt)+2<NT){WAIT_BAR(1);} else {WAIT_BAR(0);} }while(0)
  int t=1;
  for(;t+1<NT;t+=2){
    STEP(pwA0,pwA1,pwA2,pwA3,pwB0,pwB1,pwB2,pwB3,t,(t+3<NT),(t+1<NT));       ENDW(t);   RESC(); ROT();
    STEP(pwB0,pwB1,pwB2,pwB3,pwA0,pwA1,pwA2,pwA3,t+1,(t+4<NT),(t+2<NT));     ENDW(t+1); RESC(); ROT();
  }
  STEP(pwA0,pwA1,pwA2,pwA3,pwB0,pwB1,pwB2,pwB3,NT-1,false,false); RESC();
  { SBAR(); pv(o,(int)(unsigned)(uintptr_t)(vp0+sl_cur),PAFV(pwB0),PAFV(pwB1),PAFV(pwB2),PAFV(pwB3)); }
  #undef PK4
  #undef QL
  #undef PAFV
  #undef PKW
  #undef VFR
  #undef PIN
  #undef MX3
  #undef GAPA
  #undef GAPB
  #undef EX
  #undef VRD
  #undef KRD
  #undef STEP
  #undef ENDW
  {auto rr=__builtin_amdgcn_permlane32_swap(__float_as_uint(l_reg),__float_as_uint(l_reg),false,false);l_reg=__uint_as_float(rr[0])+__uint_as_float(rr[1]);}
  if(hi==0)wsf[32+r32]=l_reg;asm volatile("s_waitcnt lgkmcnt(0)":::"memory");
  float rli[16];
  #pragma unroll
  for(int r=0;r<16;++r)rli[r]=__builtin_amdgcn_rcpf(wsf[32+crow(r,hi)]);
  bf16*Ow=O+(rowbase+q0+wid*QBLK)*DM+h*D;
  { bf16*stg=(bf16*)(shm+LDS_OST)+wid*2048;
    #pragma unroll
    for(int r=0;r<16;++r){const int orow=crow(r,hi);
      #pragma unroll
      for(int d0=0;d0<2;++d0)stg[orow*64+d0*32+r32]=__float2bfloat16(o[d0][r]*rli[r]);}
    asm volatile("s_waitcnt lgkmcnt(0)":::"memory");
    #pragma unroll
    for(int i=0;i<4;++i){const int row=i*8+(lane>>3),ch=lane&7; const u32x4 v=*(const u32x4*)(stg+row*64+ch*8); ATTN_STORE16(Ow+(long)row*DM+ch*8,v);} }
  asm volatile("s_waitcnt lgkmcnt(0)\n\ts_barrier":::"memory");
  #undef DMA_K
  #undef DMA_V
  #undef KT
  #undef qrel
  #undef KEEPF
  #undef NEEDB
  #undef START
  #undef RESC
  #undef ROT
}
constexpr int ATTN_LDS_BYTES=LDS_BYTES;
#undef SBAR
#undef WAIT_BAR
}
#define GAS __attribute__((address_space(1)))
typedef GAS unsigned gu32;
#define RLX_AGENT __ATOMIC_RELAXED, __HIP_MEMORY_SCOPE_AGENT
#define XB_TMO      128
#define XB_XCNT(j)  (256  + 64 * (j))
#define XB_XSUB(j)  (1280 + 64 * (j))
#define XB_XGEN(j)  (2304 + 64 * (j))
#define XB_TOP      3328
#define XB_TOPGEN   3392
#define XCD_BAR_WORDS 3456
#define XB_SPIN_CAP (1u << 18)

__device__ __forceinline__ unsigned xb_ld(unsigned* p)              { return __hip_atomic_load(p, __ATOMIC_RELAXED, __HIP_MEMORY_SCOPE_AGENT); }
__device__ __forceinline__ unsigned xb_add(unsigned* p, unsigned v) { return __hip_atomic_fetch_add(p, v, __ATOMIC_RELAXED, __HIP_MEMORY_SCOPE_AGENT); }
__device__ __forceinline__ unsigned xb_xcc_id() { return (unsigned)__builtin_amdgcn_s_getreg((3 << 11) | 20) & 0xFu; }
#define XB_SPIN(cond, bar) do { unsigned _sp = 0; while (cond) { __builtin_amdgcn_s_sleep(1); \
    if ((++_sp & 255u) == 0u) { if (xb_ld(&(bar)[XB_TMO])) break; if (_sp > XB_SPIN_CAP) { atomicAdd(&(bar)[XB_TMO], 1u); break; } } } } while (0)

struct XcdBarrier {
    unsigned* bar; unsigned x;
    volatile LAS unsigned* st;
};

__device__ __forceinline__ XcdBarrier xcd_barrier_post(unsigned* bar, volatile LAS unsigned* st, const bool t0) {
    XcdBarrier b; b.bar = bar; b.x = xb_xcc_id(); b.st = st;
    if (t0) (void)xb_add(&bar[XB_XCNT(b.x)], 1u);
    return b;
}
__device__ __forceinline__ void xcd_barrier_complete(unsigned* bar, unsigned x, unsigned& nloc, unsigned& nx) {
    const unsigned G = gridDim.x * gridDim.y * gridDim.z;
    unsigned sum, cnt, mine, sp = 0u;
    for (;;) {
        sum = 0u; cnt = 0u; mine = 0u;
#pragma unroll
        for (unsigned j = 0; j < 16; ++j) { const unsigned c = xb_ld(&bar[XB_XCNT(j)]); sum += c; cnt += (c > 0u) ? 1u : 0u; mine = (j == x) ? c : mine; }
        if (sum == G) break;
        __builtin_amdgcn_s_sleep(1);
        if ((++sp & 255u) == 0u) { if (xb_ld(&bar[XB_TMO])) break; if (sp > XB_SPIN_CAP) { atomicAdd(&bar[XB_TMO], 1u); break; } }
    }
    nloc = mine > 0u ? mine : 1u; nx = cnt > 0u ? cnt : 1u;
}

__device__ __forceinline__ void xcd_barrier(const XcdBarrier& b, const bool t0) {
    asm volatile("s_waitcnt vmcnt(0)" ::: "memory");
    __syncthreads();
    if (t0) {
        unsigned* bar = b.bar;
        __builtin_amdgcn_s_waitcnt(0);
        unsigned nloc = b.st[0], nx = b.st[1];
        if (nloc == 0u) { xcd_barrier_complete(bar, b.x, nloc, nx); b.st[0] = nloc; b.st[1] = nx; }
        const unsigned old = xb_add(&bar[XB_XSUB(b.x)], 1u);
        const unsigned gen = old / nloc;
        if (old + 1u == (gen + 1u) * nloc) {
            __builtin_amdgcn_fence(__ATOMIC_RELEASE, "agent");
            asm volatile("s_waitcnt vmcnt(0)" ::: "memory");
            const unsigned og = xb_add(&bar[XB_TOP], 1u);
            const unsigned tg = og / nx;
            if (og + 1u == (tg + 1u) * nx) xb_add(&bar[XB_TOPGEN], 1u);
            else XB_SPIN(xb_ld(&bar[XB_TOPGEN]) == tg, bar);
            __builtin_amdgcn_fence(__ATOMIC_ACQUIRE, "agent");
            xb_add(&bar[XB_XGEN(b.x)], 1u);
            asm volatile("s_waitcnt vmcnt(0)" ::: "memory");
        } else {
            XB_SPIN(xb_ld(&bar[XB_XGEN(b.x)]) == gen, bar);
            __builtin_amdgcn_fence(__ATOMIC_ACQUIRE, "agent");
            asm volatile("s_waitcnt vmcnt(0)" ::: "memory");
        }
    }
    __syncthreads();
}
constexpr int NWAVES = 8;
constexpr int RING_OFF = 0, RING_BYTES = 131072;
constexpr int LDSCTL_OFF = RING_BYTES;
constexpr int LDS_BYTES = 147456;
constexpr int CW_BAR = 4096;
#ifndef PROBE_EXTRA
#define PROBE_EXTRA 0
#endif
#ifndef PROBE_KIND
#define PROBE_KIND K_ATTN
#endif
constexpr int N_PHASES = 17 + PROBE_EXTRA;
constexpr int CW_FIN = 16384;
enum { K_PROLOGUE = 0, K_POOL, K_POOLGEMM_UNUSED, K_UP, K_DOWN, K_QGEMM, K_ATTN, K_WO, K_FINAL };
#ifndef REP_KIND
#define REP_KIND -1
#endif
#ifndef REP_N
#define REP_N 2
#endif
constexpr size_t WS_DUMMY = 268 * MiB;
#ifndef NAIVE_ATTN
#define NAIVE_ATTN 0
#endif

struct Args { Params p; int ph_lo, ph_hi; };

__global__ void __launch_bounds__(NWAVES * 64, 2) mk_fwd(Args args) {
    extern __shared__ __attribute__((aligned(16))) unsigned char lds_raw[];
    asm volatile("s_nop 0\n\ts_nop 0\n\ts_nop 0\n\ts_nop 0\n\ts_nop 0\n\ts_nop 0\n\ts_nop 0" ::: "memory");
    LAS unsigned char* lds = (LAS unsigned char*)lds_raw;
    typedef const __attribute__((address_space(4))) Args* KArgs;
    const int tid0 = threadIdx.x, wave = __builtin_amdgcn_readfirstlane(tid0 >> 6);
    const int G = gridDim.x;
    unsigned char* ws0 = args.p.ws;
    volatile LAS unsigned* LCTL = (volatile LAS unsigned*)(lds + LDSCTL_OFF);
    for (int u = tid0; u < (LDS_BYTES - LDSCTL_OFF) / 4; u += NWAVES * 64) ((LAS unsigned*)(lds + LDSCTL_OFF))[u] = 0u;
    __syncthreads();
    const int lo = args.ph_lo, hi = args.ph_hi;
    const bool multi = (hi - lo) > 1;
    XcdBarrier bar; bar.bar = (unsigned*)(ws0 + WS_CTL) + CW_BAR; bar.x = 0; bar.st = nullptr;
    if (multi) bar = xcd_barrier_post((unsigned*)(ws0 + WS_CTL) + CW_BAR, LCTL + 8, tid0 == 0);
    const int gw = blockIdx.x * NWAVES + wave, NGW = G * NWAVES;

    static_assert(WS_V - WS_K == (size_t)M * D * 2, "V follows K");
    for (int ph = lo; ph < hi; ++ph) {
#define IS_T0 (wave == 0 && __builtin_amdgcn_mbcnt_hi(~0u, __builtin_amdgcn_mbcnt_lo(~0u, 0u)) == 0u)
#define PHASE_TID int lane = __builtin_amdgcn_mbcnt_hi(~0u, __builtin_amdgcn_mbcnt_lo(~0u, 0u)); asm volatile("" : "+v"(lane)); const int tid = wave * 64 + lane; (void)tid
        KArgs ka = (KArgs)__builtin_amdgcn_kernarg_segment_ptr(); asm volatile("" : "+s"(ka));
        size_t wsz = 0; asm volatile("" : "+s"(wsz)); unsigned char* ws = ka->p.ws + wsz;
        const int cb = (ph == 2 || ph == 3) ? 1 : 0;
        bf16_t* XB = (bf16_t*)(ws + (cb ? WS_K : WS_XB)); float* SS = (float*)(ws + (cb ? WS_SS2 : WS_SS)); bf16_t* ACT = (bf16_t*)(ws + WS_ACT);
        bf16_t* Kb = (bf16_t*)(ws + WS_K); bf16_t* Vb = (bf16_t*)(ws + WS_V); bf16_t* Qb = (bf16_t*)(ws + WS_Q); bf16_t* Ob = (bf16_t*)(ws + WS_O); bf16_t* Dp = (bf16_t*)(ws + WS_DP);
        float* KMP = (float*)(ws + WS_KMP); float* biasT = (float*)(ws + WS_BIAS);
        int kind, layer;
        if (ph == 0) { kind = K_PROLOGUE; layer = 0; }
        else if (PROBE_EXTRA > 0 && ph >= 17) { kind = PROBE_KIND; layer = 3; }
        else if (ph <= 6) { layer = (ph - 1) / 3; const int s = (ph - 1) % 3; kind = s == 0 ? K_POOL : (s == 1 ? K_UP : K_DOWN); }
        else { const int q = ph - 7; layer = 2 + q / 5; const int s = q % 5; kind = s == 0 ? K_QGEMM : (s == 1 ? K_ATTN : (s == 2 ? K_WO : (s == 3 ? K_UP : K_DOWN))); }

        const int reps = (REP_KIND >= 0 && kind == REP_KIND) ? REP_N : 1;
        for (int rep = 0; rep < reps; ++rep) {
        if (kind == K_PROLOGUE) { PHASE_TID;
            LAS float* scr = (LAS float*)(lds + RING_OFF + wave * 16384);
            Params p; p.x = ka->p.x; p.norm_mixer = ka->p.norm_mixer; p.norm_ffn = ka->p.norm_ffn; p.pool_w = ka->p.pool_w; p.pool_scale = ka->p.pool_scale; p.kv_norm = ka->p.kv_norm; p.w_kv = ka->p.w_kv; p.w_q = ka->p.w_q;
            p.w_o = ka->p.w_o; p.rel_bias = ka->p.rel_bias; p.w_gate_up = ka->p.w_gate_up; p.w_down = ka->p.w_down; p.final_norm = ka->p.final_norm; p.out = ka->p.out; p.ws = ws;
            for (int it = gw; it < IT_TOTAL; it += NGW) conv_dispatch(p, it, scr, lane);
            for (int r = gw; r < M; r += NGW) rowprep(p.x, XB, SS, r, lane);
            const int t = blockIdx.x * (NWAVES * 64) + tid;
            if (t < NH * 128) { const int h = t >> 7, d = t & 127; biasT[t] = (p.rel_bias[rel_bucket(d) * NH + h] - p.rel_bias[31 * NH + h]) * LOG2E; }
        } else if (kind == K_POOL) { PHASE_TID;
            const int ib = layer;
            const bf16_t* XBi = (const bf16_t*)(ws + (ib ? WS_K : WS_XB)); const float* SSi = (const float*)(ws + (ib ? WS_SS2 : WS_SS));
            pg8::EpiResid E; E.XB = XBi; E.XBo = (bf16_t*)(ws + (ib ? WS_XB : WS_K)); E.SS = (float*)(ws + (ib ? WS_SS : WS_SS2)); E.fout = nullptr; E.gfin = nullptr; E.slots = nullptr; E.cnt = nullptr; E.tid = tid;
            if (rep > 0) { E.XBo = (bf16_t*)(ws + WS_DUMMY); E.SS = (float*)(ws + WS_DUMMY); }
            pg8::StaticOrder S; S.init(M, D, G, (int)blockIdx.x);
            poolf::pool_phase(lds + RING_OFF, XBi, SSi, (const bf16_t*)(ws + WS_WPOOL) + (size_t)layer * 262144, S, E, tid);
        } else if (kind == K_WO || kind == K_DOWN) { PHASE_TID;
            pg8::Gemm g; pg8::EpiResid E; E.XB = XB; E.XBo = XB; E.SS = SS; g.N = D; g.a_pn_cols = 0; E.fout = nullptr; E.gfin = nullptr; E.slots = nullptr; E.cnt = nullptr; E.tid = tid;
            if (kind == K_DOWN && layer == 3 && rep == 0 && !(PROBE_EXTRA > 0 && ph >= 17)) { E.fout = ka->p.out; E.gfin = ka->p.final_norm; E.slots = (float*)(ws + WS_SS2); E.cnt = (unsigned*)(ws + WS_CTL) + CW_FIN; }
            if (kind == K_WO) { g.A = Ob; g.lda = D; g.Bt = (const bf16_t*)(ws + WS_WO) + (size_t)(layer - 2) * D * D; g.K = D; }
            else { g.A = ACT; g.lda = DFF; g.Bt = (const bf16_t*)(ws + WS_WDN) + (size_t)layer * WDN_STRIDE; g.K = DFF; }
            if (rep > 0 || (PROBE_EXTRA > 0 && ph >= 17)) { E.XBo = (bf16_t*)(ws + WS_DUMMY); E.SS = (float*)(ws + WS_DUMMY); }
            pg8::StaticOrder S; S.init(M, g.N, G, (int)blockIdx.x);
            pg8::gemm_phase<pg8::EpiResid, pg8::StaticOrder>(lds + RING_OFF, g, S, E, tid);
        } else if (kind == K_UP) { PHASE_TID;
            pg8::Gemm g; g.A = XB; g.lda = D; g.Bt = (const bf16_t*)(ws + WS_WGU) + (size_t)layer * WGU_STRIDE; g.K = D; g.N = NGU; g.a_pn_cols = 0;
            pg8::EpiSwiglu E; E.ACT = ACT; E.SS = SS; E.tid = tid; E.skip = 0;
#if defined(REP_VARIANT)
            if (rep > 0) { E.skip = 1; E.ACT = (bf16_t*)(ws + WS_DUMMY); }
#endif
#if defined(PROBE_SKIP_EPI)
            if (PROBE_EXTRA > 0 && ph >= 17) { E.skip = 1; E.ACT = (bf16_t*)(ws + WS_DUMMY); }
#endif
            pg8::rstd_table_reset(tid);
            pg8::TailHalfOrder S; S.init(M, g.N, G, (int)blockIdx.x);
            pg8::gemm_phase<pg8::EpiSwiglu, pg8::TailHalfOrder>(lds + RING_OFF, g, S, E, tid);
        } else if (kind == K_QGEMM) { PHASE_TID;
            pg8::Gemm g; g.A = XB; g.lda = D; g.K = D; g.a_pn_cols = 0;
            pg8::EpiKVQ E; E.Kb = Kb; E.Qb = Qb; E.KMP = KMP; E.SS = SS; E.tid = tid;
            if (layer == 2) { g.Bt = (const bf16_t*)(ws + WS_WKVQ); g.N = 3 * D; E.pn_off = 0; } else { g.Bt = (const bf16_t*)(ws + WS_WQ1); g.N = D; E.pn_off = 8; }
            pg8::rstd_table_reset(tid);
            pg8::StaticOrder S; S.init(M, g.N, G, (int)blockIdx.x);
            pg8::gemm_phase<pg8::EpiKVQ, pg8::StaticOrder>(lds + RING_OFF, g, S, E, tid);
        } else if (kind == K_ATTN) { PHASE_TID;
#if NAIVE_ATTN
            const int hw = blockIdx.x * 2 + (tid >> 8), NHW = G * 2;
            for (int w = hw; w < BATCH * NH * 4; w += NHW) { const int bh = w >> 2, s = w & 3;
                attn_naive_unit(Qb, Kb, Vb, KMP, biasT, Ob, bh >> 4, bh & 15, s, tid & 255);
                attn_naive_unit(Qb, Kb, Vb, KMP, biasT, Ob, bh >> 4, bh & 15, 7 - s, tid & 255); }
#else
            const int bx = blockIdx.x, vcu = (G % 8 == 0) ? (bx % 8) * (G / 8) + bx / 8 : bx;
            for (int u2 = 2 * vcu; u2 < BATCH * NH * 8; u2 += (u2 & 1) ? 2 * G - 1 : 1) { const int pp = u2 >> 1, bh = pp >> 2, s = pp & 3, own = (u2 & 1) ? 7 - s : s;
#if defined(PROBE_ATTN_OWN0)
                if (PROBE_EXTRA > 0 && ph >= 17) attn_body::attn_unit<8>(bh >> 4, bh & 15, PROBE_ATTN_OWN0, (const attn_body::bf16*)Qb, (const attn_body::bf16*)Kb, (const attn_body::bf16*)Vb, (attn_body::bf16*)(ws + WS_DUMMY), KMP, biasT, (char*)lds_raw + RING_OFF, wave); else
#endif
#if defined(PROBE_ATTN_NOFIX)
                if (PROBE_EXTRA > 0 && ph >= 17) attn_body::attn_unit<8, true>(bh >> 4, bh & 15, own, (const attn_body::bf16*)Qb, (const attn_body::bf16*)Kb, (const attn_body::bf16*)Vb, (attn_body::bf16*)(ws + WS_DUMMY), KMP, biasT, (char*)lds_raw + RING_OFF, wave); else
#endif
#if defined(REP_VARIANT)
                if (rep > 0) attn_body::attn_unit<8, true>(bh >> 4, bh & 15, own, (const attn_body::bf16*)Qb, (const attn_body::bf16*)Kb, (const attn_body::bf16*)Vb, (attn_body::bf16*)(ws + WS_DUMMY), KMP, biasT, (char*)lds_raw + RING_OFF, wave); else
#endif
                attn_body::attn_unit<8>(bh >> 4, bh & 15, own, (const attn_body::bf16*)Qb, (const attn_body::bf16*)Kb, (const attn_body::bf16*)Vb, (attn_body::bf16*)Ob, KMP, biasT, (char*)lds_raw + RING_OFF, wave); }
#endif
        }
        if (rep + 1 < reps) xcd_barrier(bar, IS_T0);
        }
        if (multi && ph + 1 < hi) { xcd_barrier(bar, IS_T0); if (REP_KIND == 100) xcd_barrier(bar, IS_T0); }
    }
}

extern "C" void kernel_launch(void* const* d_in, const int* in_sizes, int n_in, void* d_out, int out_size, void* d_ws, size_t ws_size, hipStream_t stream) {
    static int grid = 0;
    if (grid == 0) {
        if (n_in != 13 || in_sizes[0] != M * D || out_size != M * D || ws_size < ((REP_KIND >= 0 || PROBE_EXTRA > 0) ? WS_DUMMY + 64 * MiB : WS_END)) {
            fprintf(stderr, "kernel_launch: unexpected shapes (n_in %d, in0 %d, out %d, ws %zu); nothing launched\n", n_in, n_in > 0 ? in_sizes[0] : -1, out_size, ws_size); grid = -1; return; }
        int dev = 0, cus = 0, per_cu = 0;
        if (hipGetDevice(&dev) != hipSuccess || hipDeviceGetAttribute(&cus, hipDeviceAttributeMultiprocessorCount, dev) != hipSuccess) { fprintf(stderr, "kernel_launch: device query failed\n"); grid = -1; return; }
        if (hipFuncSetAttribute((const void*)mk_fwd, hipFuncAttributeMaxDynamicSharedMemorySize, LDS_BYTES) != hipSuccess) { fprintf(stderr, "kernel_launch: hipFuncSetAttribute failed\n"); grid = -1; return; }
        if (hipOccupancyMaxActiveBlocksPerMultiprocessor(&per_cu, (const void*)mk_fwd, NWAVES * 64, LDS_BYTES) != hipSuccess || per_cu < 1) {
            fprintf(stderr, "kernel_launch: occupancy query reports %d workgroups per CU; nothing launched\n", per_cu); (void)hipGetLastError(); grid = -1; return; }
        grid = cus;
        if (grid > 256) grid = 256;
    }
    if (grid < 0) return;
    if (hipMemsetAsync((char*)d_ws + WS_CTL, 0, 1 * MiB, stream) != hipSuccess) { fprintf(stderr, "kernel_launch: hipMemsetAsync failed\n"); return; }
    Args a{};
    a.p.x = (const float*)d_in[0]; a.p.norm_mixer = (const float*)d_in[1]; a.p.norm_ffn = (const float*)d_in[2]; a.p.pool_w = (const float*)d_in[3]; a.p.pool_scale = (const float*)d_in[4];
    a.p.kv_norm = (const float*)d_in[5]; a.p.w_kv = (const float*)d_in[6]; a.p.w_q = (const float*)d_in[7]; a.p.w_o = (const float*)d_in[8]; a.p.rel_bias = (const float*)d_in[9];
    a.p.w_gate_up = (const float*)d_in[10]; a.p.w_down = (const float*)d_in[11]; a.p.final_norm = (const float*)d_in[12];
    a.p.out = (float*)d_out; a.p.ws = (unsigned char*)d_ws;
    a.ph_lo = 0; a.ph_hi = N_PHASES;
    hipLaunchKernelGGL(mk_fwd, dim3(grid), dim3(NWAVES * 64), LDS_BYTES, stream, a);
    const hipError_t le = hipPeekAtLastError();
    if (le != hipSuccess) fprintf(stderr, "kernel_launch: launch failed: %s\n", hipGetErrorName(le));
}
```
